# Optimizing an MI355X kernel written in HIP

```python
import jax, jax.numpy as jnp
from jax import lax
import numpy as np


D_MODEL = 1024
BATCH = 8
SEQ = 4096
DEPTH = 4

N_META = 16
CHUNK = 128
PAD = CHUNK - N_META
EPS = 1e-6
SSD_HEADS = 16
SSD_HEAD_DIM = 64
SSD_D_INNER = SSD_HEADS * SSD_HEAD_DIM
SSD_GROUPS = 2
SSD_HEADS_PER_GROUP = SSD_HEADS // SSD_GROUPS
SSD_STATE = 128
SSD_CONV = 4
SSD_CONV_CH = SSD_D_INNER + 2 * SSD_GROUPS * SSD_STATE
MLA_HEADS = 16
MLA_NOPE = 64
MLA_ROPE = 32
MLA_V = 64
MLA_Q_RANK = 384
MLA_KV_RANK = 256
ROPE_BASE = 10000.0
IN_SPLITS = (SSD_D_INNER, SSD_CONV_CH, SSD_HEADS, MLA_Q_RANK, MLA_KV_RANK, MLA_ROPE)
D_IN = sum(IN_SPLITS)
AB_WIDTH = SSD_D_INNER + MLA_HEADS * MLA_V
LRU_WIDTH = 1280
LRU_BLOCKS = 10
LRU_BLOCK = LRU_WIDTH // LRU_BLOCKS
LRU_CONV = 4
LRU_C = 8.0
D_FF = 4 * D_MODEL
N_EVEN = (DEPTH + 1) // 2
N_ODD = DEPTH // 2

kernel_name = 'hybrid_ssd_mla_rglru_sandwich_meta'


def rmsnorm(x, g):
    xf = x.astype(jnp.float32)
    y = xf * lax.rsqrt(jnp.mean(xf * xf, axis=-1, keepdims=True) + EPS)
    return (y * g.astype(jnp.float32)).astype(x.dtype)


def _split(x, sizes):
    offs = np.cumsum(sizes)[:-1].tolist()
    return jnp.split(x, offs, axis=-1)


def pad_front(x, n):
    return jnp.pad(x, [(0, 0), (n, 0)] + [(0, 0)] * (x.ndim - 2))


def causal_dwconv(x, w, b):
    k, t = w.shape[0], x.shape[1]
    xp = jnp.pad(x, ((0, 0), (k - 1, 0), (0, 0)))
    out = b
    for i in range(k):
        out = out + xp[:, i:i + t] * w[i]
    return out


def rope_tables(t, dim):
    inv = ROPE_BASE ** (-jnp.arange(0, dim, 2, dtype=jnp.float32) / dim)
    ang = jnp.arange(t, dtype=jnp.float32)[:, None] * inv[None, :]
    return jnp.cos(ang), jnp.sin(ang)


def apply_rope(x, cos, sin):
    half = x.shape[-1] // 2
    x1, x2 = x[..., :half], x[..., half:]
    return jnp.concatenate([x1 * cos - x2 * sin, x2 * cos + x1 * sin], axis=-1).astype(x.dtype)


def ssd_chunked_scan(xdt, da, bm, cm):
    b, tp = xdt.shape[:2]
    nc = tp // CHUNK
    g, k = SSD_GROUPS, SSD_HEADS_PER_GROUP
    x = xdt.reshape(b, nc, CHUNK, g, k, SSD_HEAD_DIM)
    a = da.reshape(b, nc, CHUNK, g, k).transpose(0, 1, 3, 4, 2)
    bc = bm.reshape(b, nc, CHUNK, g, SSD_STATE)
    cc = cm.reshape(b, nc, CHUNK, g, SSD_STATE)
    a_cs = jnp.cumsum(a, axis=-1)
    causal = jnp.tril(jnp.ones((CHUNK, CHUNK), dtype=bool))
    seg = a_cs[..., :, None] - a_cs[..., None, :]
    decay_in = jnp.exp(jnp.where(causal, seg, -jnp.inf))
    cb = jnp.einsum('bclgn,bcsgn->bcgls', cc, bc)
    y_diag = jnp.einsum('bcgkls,bcsgkp->bclgkp', cb[:, :, :, None] * decay_in, x)
    decay_to_end = jnp.exp(a_cs[..., -1:] - a_cs)
    states = jnp.einsum('bclgn,bcgkl,bclgkp->bcgkpn', bc, decay_to_end, x).astype(jnp.float32)
    chunk_decay = jnp.exp(a_cs[..., -1])

    def step(h, inp):
        dec, st = inp
        return dec[..., None, None] * h + st, h

    h0 = jnp.zeros((b, g, k, SSD_HEAD_DIM, SSD_STATE), jnp.float32)
    _, prev = lax.scan(step, h0, (jnp.moveaxis(chunk_decay, 1, 0), jnp.moveaxis(states, 1, 0)))
    prev = jnp.moveaxis(prev, 0, 1)
    y_off = jnp.einsum('bclgn,bcgkpn,bcgkl->bclgkp', cc.astype(jnp.float32), prev, jnp.exp(a_cs))
    y = y_diag.astype(jnp.float32) + y_off
    return y.reshape(b, tp, SSD_HEADS, SSD_HEAD_DIM).astype(xdt.dtype)


def ssd_branch(z, xbc, dt_raw, conv_w, conv_b, dt_bias, a_log, d_skip, norm_g):
    b, t, _ = z.shape
    xbc = jax.nn.silu(causal_dwconv(xbc, conv_w, conv_b))
    xs, bm, cm = _split(xbc, (SSD_D_INNER, SSD_GROUPS * SSD_STATE, SSD_GROUPS * SSD_STATE))
    dt = jax.nn.softplus(dt_raw.astype(jnp.float32) + dt_bias.astype(jnp.float32))
    a = -jnp.exp(a_log.astype(jnp.float32))
    xh = xs.reshape(b, t, SSD_HEADS, SSD_HEAD_DIM)
    xdt = pad_front(xh * dt[..., None].astype(xh.dtype), PAD)
    da = pad_front(dt * a, PAD)
    bm = pad_front(bm.reshape(b, t, SSD_GROUPS, SSD_STATE), PAD)
    cm = pad_front(cm.reshape(b, t, SSD_GROUPS, SSD_STATE), PAD)
    y = ssd_chunked_scan(xdt, da, bm, cm)[:, PAD:]
    y = y + d_skip[:, None] * xh
    y = y.reshape(b, t, SSD_D_INNER)
    return rmsnorm(y * jax.nn.silu(z), norm_g)


def mla_branch(cq, ckv, krope, q_norm_g, w_q_up, kv_norm_g, w_kv_up, cos, sin):
    b, t, _ = cq.shape
    q = (rmsnorm(cq, q_norm_g) @ w_q_up).reshape(b, t, MLA_HEADS, MLA_NOPE + MLA_ROPE)
    q = jnp.concatenate([q[..., :MLA_NOPE], apply_rope(q[..., MLA_NOPE:], cos[:, None], sin[:, None])], axis=-1)
    kv = (rmsnorm(ckv, kv_norm_g) @ w_kv_up).reshape(b, t, MLA_HEADS, MLA_NOPE + MLA_V)
    k_r = apply_rope(krope, cos, sin)
    k = jnp.concatenate([kv[..., :MLA_NOPE],
                         jnp.broadcast_to(k_r[:, :, None], (b, t, MLA_HEADS, MLA_ROPE))], axis=-1)
    v = kv[..., MLA_NOPE:]
    qp, kp, vp = pad_front(q, PAD), pad_front(k, PAD), pad_front(v, PAD)
    tp = t + PAD
    nb = tp // CHUNK
    scale = (MLA_NOPE + MLA_ROPE) ** -0.5
    kidx = jnp.arange(tp)

    def block(j):
        q_blk = lax.dynamic_slice_in_dim(qp, j * CHUNK, CHUNK, axis=1)
        s = jnp.einsum('bqhd,bkhd->bhqk', q_blk, kp).astype(jnp.float32) * scale
        qidx = j * CHUNK + jnp.arange(CHUNK)
        mask = (kidx[None, :] <= qidx[:, None]) & (kidx[None, :] >= PAD)
        s = jnp.where(mask, s, -1e30)
        p = jax.nn.softmax(s, axis=-1).astype(vp.dtype)
        return jnp.einsum('bhqk,bkhd->bqhd', p, vp)

    o = lax.map(block, jnp.arange(nb))
    o = o.transpose(1, 0, 2, 3, 4).reshape(b, tp, MLA_HEADS * MLA_V)
    return o[:, PAD:]


def mixer_ssd_mla(h, w_in, conv_w, conv_b, dt_bias, a_log, d_skip, ssd_norm_g,
                  q_norm_g, w_q_up, kv_norm_g, w_kv_up, w_out, cos, sin):
    z, xbc, dt_raw, cq, ckv, krope = _split(h @ w_in, IN_SPLITS)
    y_ssd = ssd_branch(z, xbc, dt_raw, conv_w, conv_b, dt_bias, a_log, d_skip, ssd_norm_g)
    y_att = mla_branch(cq, ckv, krope, q_norm_g, w_q_up, kv_norm_g, w_kv_up, cos, sin)
    return jnp.concatenate([y_ssd, y_att], axis=-1) @ w_out


def _lru_combine(c1, c2):
    a1, b1 = c1
    a2, b2 = c2
    return a1 * a2, a2 * b1 + b2


def mixer_rglru(h, w_x, w_y, conv_w, conv_b, w_a, b_a, w_i, b_i, lam, w_out):
    b, t, _ = h.shape
    gate = jax.nn.gelu(h @ w_y)
    xr = causal_dwconv(h @ w_x, conv_w, conv_b)
    xb = xr.reshape(b, t, LRU_BLOCKS, LRU_BLOCK)
    r = jax.nn.sigmoid(jnp.einsum('btni,nij->btnj', xb, w_a).reshape(b, t, LRU_WIDTH) + b_a)
    i = jax.nn.sigmoid(jnp.einsum('btni,nij->btnj', xb, w_i).reshape(b, t, LRU_WIDTH) + b_i)
    log_a = -LRU_C * r.astype(jnp.float32) * jax.nn.softplus(-lam.astype(jnp.float32))
    a = jnp.exp(log_a)
    u = jnp.sqrt(-jnp.expm1(2.0 * log_a)) * (i * xr).astype(jnp.float32)
    _, hs = lax.associative_scan(_lru_combine, (a, u), axis=1)
    return (hs.astype(h.dtype) * gate) @ w_out


def _normal(k, shape, fan_in):
    return jax.random.normal(k, shape, jnp.float32) * (fan_in ** -0.5)


def setup_inputs(seed: int = 0) -> dict:
    key = jax.random.key(seed)
    ks = iter(jax.random.split(key, 40))
    gain = lambda k, shape: 1.0 + 0.02 * jax.random.normal(k, shape, jnp.float32)
    small = lambda k, shape: 0.02 * jax.random.normal(k, shape, jnp.float32)
    x = jax.random.normal(next(ks), (BATCH, SEQ, D_MODEL), jnp.float32)
    meta_tokens = jax.random.normal(next(ks), (N_META, D_MODEL), jnp.float32)
    mix_pre_g = gain(next(ks), (DEPTH, D_MODEL))
    mix_post_g = gain(next(ks), (DEPTH, D_MODEL))
    mlp_pre_g = gain(next(ks), (DEPTH, D_MODEL))
    mlp_post_g = gain(next(ks), (DEPTH, D_MODEL))
    w_up = _normal(next(ks), (DEPTH, D_MODEL, D_FF), D_MODEL)
    w_down = _normal(next(ks), (DEPTH, D_FF, D_MODEL), D_FF)
    w_in = _normal(next(ks), (N_EVEN, D_MODEL, D_IN), D_MODEL)
    ssd_conv_w = _normal(next(ks), (N_EVEN, SSD_CONV, SSD_CONV_CH), SSD_CONV)
    ssd_conv_b = small(next(ks), (N_EVEN, SSD_CONV_CH))
    dt = jnp.exp(jax.random.uniform(next(ks), (N_EVEN, SSD_HEADS), jnp.float32,
                                    minval=np.log(1e-3), maxval=np.log(1e-1)))
    ssd_dt_bias = dt + jnp.log(-jnp.expm1(-dt))
    ssd_a_log = jnp.log(jax.random.uniform(next(ks), (N_EVEN, SSD_HEADS), jnp.float32, minval=1.0, maxval=16.0))
    ssd_d = 1.0 + 0.1 * jax.random.normal(next(ks), (N_EVEN, SSD_HEADS), jnp.float32)
    ssd_norm_g = gain(next(ks), (N_EVEN, SSD_D_INNER))
    mla_q_norm_g = gain(next(ks), (N_EVEN, MLA_Q_RANK))
    mla_w_q_up = _normal(next(ks), (N_EVEN, MLA_Q_RANK, MLA_HEADS * (MLA_NOPE + MLA_ROPE)), MLA_Q_RANK)
    mla_kv_norm_g = gain(next(ks), (N_EVEN, MLA_KV_RANK))
    mla_w_kv_up = _normal(next(ks), (N_EVEN, MLA_KV_RANK, MLA_HEADS * (MLA_NOPE + MLA_V)), MLA_KV_RANK)
    w_out_ab = _normal(next(ks), (N_EVEN, AB_WIDTH, D_MODEL), AB_WIDTH)
    rg_w_x = _normal(next(ks), (N_ODD, D_MODEL, LRU_WIDTH), D_MODEL)
    rg_w_y = _normal(next(ks), (N_ODD, D_MODEL, LRU_WIDTH), D_MODEL)
    rg_conv_w = _normal(next(ks), (N_ODD, LRU_CONV, LRU_WIDTH), LRU_CONV)
    rg_conv_b = small(next(ks), (N_ODD, LRU_WIDTH))
    rg_w_a = _normal(next(ks), (N_ODD, LRU_BLOCKS, LRU_BLOCK, LRU_BLOCK), LRU_BLOCK)
    rg_b_a = small(next(ks), (N_ODD, LRU_WIDTH))
    rg_w_i = _normal(next(ks), (N_ODD, LRU_BLOCKS, LRU_BLOCK, LRU_BLOCK), LRU_BLOCK)
    rg_b_i = small(next(ks), (N_ODD, LRU_WIDTH))
    a8 = jax.random.uniform(next(ks), (N_ODD, LRU_WIDTH), jnp.float32, minval=0.9, maxval=0.999)
    base = a8 ** (1.0 / LRU_C)
    rg_lambda = jnp.log(base) - jnp.log1p(-base)
    rg_w_out = _normal(next(ks), (N_ODD, LRU_WIDTH, D_MODEL), LRU_WIDTH)
    return {'x': x, 'meta_tokens': meta_tokens, 'mix_pre_g': mix_pre_g, 'mix_post_g': mix_post_g,
            'mlp_pre_g': mlp_pre_g, 'mlp_post_g': mlp_post_g, 'w_up': w_up, 'w_down': w_down,
            'w_in': w_in, 'ssd_conv_w': ssd_conv_w, 'ssd_conv_b': ssd_conv_b, 'ssd_dt_bias': ssd_dt_bias,
            'ssd_a_log': ssd_a_log, 'ssd_d': ssd_d, 'ssd_norm_g': ssd_norm_g,
            'mla_q_norm_g': mla_q_norm_g, 'mla_w_q_up': mla_w_q_up, 'mla_kv_norm_g': mla_kv_norm_g,
            'mla_w_kv_up': mla_w_kv_up, 'w_out_ab': w_out_ab, 'rg_w_x': rg_w_x, 'rg_w_y': rg_w_y,
            'rg_conv_w': rg_conv_w, 'rg_conv_b': rg_conv_b, 'rg_w_a': rg_w_a, 'rg_b_a': rg_b_a,
            'rg_w_i': rg_w_i, 'rg_b_i': rg_b_i, 'rg_lambda': rg_lambda, 'rg_w_out': rg_w_out}


def reference(x, meta_tokens, mix_pre_g, mix_post_g, mlp_pre_g, mlp_post_g, w_up, w_down,
              w_in, ssd_conv_w, ssd_conv_b, ssd_dt_bias, ssd_a_log, ssd_d, ssd_norm_g,
              mla_q_norm_g, mla_w_q_up, mla_kv_norm_g, mla_w_kv_up, w_out_ab,
              rg_w_x, rg_w_y, rg_conv_w, rg_conv_b, rg_w_a, rg_b_a, rg_w_i, rg_b_i, rg_lambda, rg_w_out):
    b = x.shape[0]
    meta = jnp.broadcast_to(meta_tokens[None].astype(x.dtype), (b, N_META, D_MODEL))
    h = jnp.concatenate([meta, x], axis=1)
    cos, sin = rope_tables(h.shape[1], MLA_ROPE)
    for layer in range(DEPTH):
        hn = rmsnorm(h, mix_pre_g[layer])
        if layer % 2 == 0:
            e = layer // 2
            m = mixer_ssd_mla(hn, w_in[e], ssd_conv_w[e], ssd_conv_b[e], ssd_dt_bias[e], ssd_a_log[e],
                              ssd_d[e], ssd_norm_g[e], mla_q_norm_g[e], mla_w_q_up[e], mla_kv_norm_g[e],
                              mla_w_kv_up[e], w_out_ab[e], cos, sin)
        else:
            o = layer // 2
            m = mixer_rglru(hn, rg_w_x[o], rg_w_y[o], rg_conv_w[o], rg_conv_b[o], rg_w_a[o], rg_b_a[o],
                            rg_w_i[o], rg_b_i[o], rg_lambda[o], rg_w_out[o])
        h = h + rmsnorm(m, mix_post_g[layer])
        hn = rmsnorm(h, mlp_pre_g[layer])
        u = jnp.square(jax.nn.relu(hn @ w_up[layer]))
        h = h + rmsnorm(u @ w_down[layer], mlp_post_g[layer])
    return h[:, N_META:]
```

```cpp
#include <hip/hip_runtime.h>
#include <hip/hip_cooperative_groups.h>
#include <cstdio>
#include <cstdint>
#include <cmath>
namespace cg = cooperative_groups;
#ifndef PROBE
#define PROBE 0
#endif
__device__ __forceinline__ int tid_from(int wv) { int t; asm volatile("v_mbcnt_lo_u32_b32 %0, -1, 0\n\tv_mbcnt_hi_u32_b32 %0, -1, %0\n\tv_lshl_add_u32 %0, %1, 6, %0" : "=&v"(t) : "s"(wv)); return t; }
#define tid_opaque() tid_from(wv_)
namespace pg8 {
#define PG8_LAS __attribute__((address_space(3)))
typedef unsigned short bf16_t;
typedef short bf16x8 __attribute__((ext_vector_type(8)));
typedef float f32x4 __attribute__((ext_vector_type(4)));
typedef unsigned u32x4 __attribute__((ext_vector_type(4)));
constexpr int BM = 256, BK = 64, HALF = 128, HTB = HALF * BK * 2  , STAGE_BYTES = 8 * HTB, NXCD = 8, WGM = 8;

__host__ __device__ __forceinline__ int lds_byte(int r, int c) { const int st = (r >> 4) * 2 + (c >> 5), rr = r & 15, cc = c & 31, ob = rr * 64 + cc * 2; return st * 1024 + (ob ^ (((ob >> 9) & 1) << 5)); }
__host__ __device__ __forceinline__ void stage_rc(int b, int& R, int& C) { const int st = b / 1024, sb = b % 1024, swz = sb ^ (((sb >> 9) & 1) << 5); R = (st >> 1) * 16 + swz / 64; C = (st & 1) * 32 + (swz % 64) / 2; }
__host__ __device__ __forceinline__ int perm32(int rho) { const int n = rho >> 4, i = rho & 15; return 8 * (i >> 2) + 4 * n + (i & 3); }

struct Unit { int pm, pn; };
struct Gemm { const bf16_t* A; const bf16_t* Bt; int M, N, K, lda, ldb, a_pn, half_pm, nsplit_n, kofs; };

struct StaticOrder {
    int nM, nN, nwg, G, c;
    __host__ __device__ void init(int M, int N, int G_, int c_) { nM = M / BM; nN = N / BM; nwg = nM * nN; G = G_; c = c_; }
    __host__ __device__ bool next(int i, Unit& u) const {
        const long L = (long)i * G + c; if (L >= nwg) return false;
        int wgid = (int)L; { const int q = nwg / NXCD, r = nwg % NXCD, xcd = wgid % NXCD, off = wgid / NXCD; wgid = (xcd < r ? xcd * (q + 1) : r * (q + 1) + (xcd - r) * q) + off; }
        const int nig = WGM * nN, gid = wgid / nig, fm = gid * WGM, gsz = (nM - fm) < WGM ? (nM - fm) : WGM;
        u.pm = fm + ((wgid % nig) % gsz); u.pn = (wgid % nig) / gsz; return true;
    }
    __device__ __forceinline__ void a_ready(const Unit&) const {}
    __device__ __forceinline__ void done(const Unit&) const {}
};

__device__ __forceinline__ unsigned cvt_pk_bf16(float lo, float hi) { unsigned r; asm volatile("v_cvt_pk_bf16_f32 %0, %1, %2" : "=v"(r) : "v"(lo), "v"(hi)); return r; }
typedef float f32x2 __attribute__((ext_vector_type(2)));
template <class Epi, class Sched, bool ALIGN_EPI = false, bool SP2 = false>
__device__ __forceinline__ void gemm_phase(int wv_, PG8_LAS unsigned char* lds, const Gemm g, const Sched& S, const Epi& E) {
    const int tid = tid_opaque(), wid = __builtin_amdgcn_readfirstlane(tid >> 6), lane = tid & 63, wr = wid >> 2, wc = wid & 3, fr = lane & 15, fq = lane >> 4;
    const int K = g.K, nt = K / BK;
    unsigned voffA[2], voffB[2];
#pragma unroll
    for (int i = 0; i < 2; ++i) { int R, C; stage_rc(tid * 16 + i * 8192, R, C); const int Rb = Epi::PERM ? ((R & ~31) + perm32(R & 31)) : R;
        voffA[i] = (unsigned)(R * g.lda + C) * 2u; voffB[i] = (unsigned)(Rb * g.ldb + C) * 2u; }
    const size_t kstep = (size_t)(BK * 2);
    const size_t hstepA = (size_t)HALF * g.lda * 2, hstepB = (size_t)HALF * g.ldb * 2;
    const size_t tstepA = 2 * hstepA, tstepB = 2 * hstepB, pnA = (size_t)g.a_pn * 2;
    const unsigned ldsw = (unsigned)wid * 1024u;
    const int aoff = lds_byte(wr * 64 + fr, fq * 8), boff = lds_byte(wc * 32 + fr, fq * 8);
#define PG8_SA(b, h) (((b) * 2 + (h)) * HTB)
#define PG8_SB(b, h) ((4 + (b) * 2 + (h)) * HTB)
#define PG8_STAGE(bufoff, gbase, voff) do { _Pragma("unroll") for (int _i = 0; _i < 2; ++_i) \
        __builtin_amdgcn_global_load_lds((const unsigned*)((const char*)(gbase) + (voff)[_i]), (PG8_LAS unsigned*)(lds + (bufoff) + ldsw + _i * 8192), 16, 0, 0); } while (0)
#define PG8_LDA(dst, b, h) do { _Pragma("unroll") for (int m = 0; m < 4; ++m) _Pragma("unroll") for (int k = 0; k < 2; ++k) dst[m][k] = *(const PG8_LAS bf16x8*)(lds + PG8_SA(b, h) + aoff + m * 2048 + k * 1024); } while (0)
#define PG8_LDB(dst, b, h) do { _Pragma("unroll") for (int n = 0; n < 2; ++n) _Pragma("unroll") for (int k = 0; k < 2; ++k) dst[n][k] = *(const PG8_LAS bf16x8*)(lds + PG8_SB(b, h) + boff + n * 2048 + k * 1024); } while (0)
#define PG8_MMA(ai, bj, At, Bt) do { __builtin_amdgcn_s_setprio(1); _Pragma("unroll") for (int m = 0; m < 4; ++m) _Pragma("unroll") for (int n = 0; n < 2; ++n) _Pragma("unroll") for (int k = 0; k < 2; ++k) \
        acc[ai][bj][m][n] = __builtin_amdgcn_mfma_f32_16x16x32_bf16(Bt[n][k], At[m][k], acc[ai][bj][m][n], 0, 0, 0); __builtin_amdgcn_s_setprio(0); } while (0)
#define PG8_WAIT_V(n) asm volatile("s_waitcnt vmcnt(" #n ")" ::: "memory")
#define PG8_WAIT_L(n) asm volatile("s_waitcnt lgkmcnt(" #n ")" ::: "memory")
#define PG8_BAR __builtin_amdgcn_s_barrier()
#define PG8_SCHED __builtin_amdgcn_sched_barrier(0)
    Unit cur, nxt; int ui = 0;
    if (!S.next(0, cur)) return;
    f32x4 acc[2][2][4][2];
#pragma unroll
    for (int a = 0; a < 2; ++a)
#pragma unroll
        for (int b = 0; b < 2; ++b)
#pragma unroll
            for (int m = 0; m < 4; ++m)
#pragma unroll
                for (int n = 0; n < 2; ++n) acc[a][b][m][n] = (f32x4){0.f, 0.f, 0.f, 0.f};
    bf16x8 At[4][2], B0[2][2], B1[2][2];
    const char* cA = (const char*)g.A + (size_t)cur.pm * tstepA + (size_t)(cur.pn % g.nsplit_n) * pnA + (size_t)(cur.pn / g.nsplit_n) * g.kofs; const char* cB = (const char*)g.Bt + (size_t)(cur.pn % g.nsplit_n) * tstepB + (size_t)(cur.pn / g.nsplit_n) * g.kofs;
    S.a_ready(cur);
    if constexpr (SP2) {
        PG8_STAGE(PG8_SB(0, 0), cB, voffB); PG8_STAGE(PG8_SB(0, 1), cB + hstepB, voffB); PG8_STAGE(PG8_SA(0, 0), cA, voffA); PG8_STAGE(PG8_SA(0, 1), cA + hstepA, voffA);
        if (wr == 1) PG8_BAR;
        PG8_WAIT_V(2); PG8_BAR;
        PG8_STAGE(PG8_SB(1, 0), cB + kstep, voffB); PG8_STAGE(PG8_SA(1, 0), cA + kstep, voffA); PG8_STAGE(PG8_SB(1, 1), cB + hstepB + kstep, voffB);
        PG8_WAIT_V(6); PG8_BAR;
    } else {
        PG8_STAGE(PG8_SB(0, 0), cB, voffB); PG8_STAGE(PG8_SA(0, 0), cA, voffA); PG8_STAGE(PG8_SB(0, 1), cB + hstepB, voffB); PG8_STAGE(PG8_SA(0, 1), cA + hstepA, voffA);
        if (wr == 1) PG8_BAR;
        PG8_WAIT_V(4); PG8_BAR;
        PG8_STAGE(PG8_SB(1, 0), cB + kstep, voffB); PG8_STAGE(PG8_SA(1, 0), cA + kstep, voffA); PG8_STAGE(PG8_SB(1, 1), cB + hstepB + kstep, voffB);
        PG8_WAIT_V(6); PG8_BAR;
    }
    for (;;) {
        const bool has_next = S.next(ui + 1, nxt);
        const char* nA = has_next ? (const char*)g.A + (size_t)nxt.pm * tstepA + (size_t)(nxt.pn % g.nsplit_n) * pnA + (size_t)(nxt.pn / g.nsplit_n) * g.kofs : cA; const char* nB = has_next ? (const char*)g.Bt + (size_t)(nxt.pn % g.nsplit_n) * tstepB + (size_t)(nxt.pn / g.nsplit_n) * g.kofs : cB;
        const bool full_ = (cur.pm != g.half_pm);
        for (int t = 0; t < nt; t += 2) {
            const bool last = (t == nt - 2);
            const char* a1 = cA + (size_t)(t + 1) * kstep;
            const char* a2 = last ? nA : cA + (size_t)(t + 2) * kstep; const char* b2 = last ? nB : cB + (size_t)(t + 2) * kstep;
            const char* a3 = a2 + kstep; const char* b3 = b2 + kstep;
            if (last && has_next) S.a_ready(nxt);
            if constexpr (SP2) {
            PG8_LDB(B0, 0, 0); PG8_LDB(B1, 0, 1); PG8_SCHED; PG8_LDA(At, 0, 0); PG8_STAGE(PG8_SA(1, 1), a1 + hstepA, voffA);
            PG8_WAIT_V(8); PG8_WAIT_L(0); PG8_BAR; PG8_MMA(0, 0, At, B0); PG8_MMA(0, 1, At, B1); PG8_BAR; PG8_SCHED;
            PG8_LDA(At, 0, 1); PG8_STAGE(PG8_SB(0, 0), b2, voffB); PG8_STAGE(PG8_SB(0, 1), b2 + hstepB, voffB); PG8_STAGE(PG8_SA(0, 0), a2, voffA);
            PG8_WAIT_V(8); PG8_WAIT_L(0); PG8_BAR; if (full_) { PG8_MMA(1, 0, At, B0); PG8_MMA(1, 1, At, B1); } PG8_BAR; PG8_SCHED;
            PG8_LDB(B0, 1, 0); PG8_LDB(B1, 1, 1); PG8_SCHED; PG8_LDA(At, 1, 0); PG8_STAGE(PG8_SA(0, 1), a2 + hstepA, voffA);
            PG8_WAIT_V(8); PG8_WAIT_L(0); PG8_BAR; PG8_MMA(0, 0, At, B0); PG8_MMA(0, 1, At, B1); PG8_BAR; PG8_SCHED;
            PG8_LDA(At, 1, 1); PG8_STAGE(PG8_SB(1, 0), b3, voffB); PG8_STAGE(PG8_SB(1, 1), b3 + hstepB, voffB); PG8_STAGE(PG8_SA(1, 0), a3, voffA);
            PG8_WAIT_V(8); PG8_WAIT_L(0); PG8_BAR; if (full_) { PG8_MMA(1, 0, At, B0); PG8_MMA(1, 1, At, B1); } PG8_BAR; PG8_SCHED;
            } else {
            PG8_LDB(B0, 0, 0); PG8_SCHED; PG8_LDA(At, 0, 0); PG8_STAGE(PG8_SA(1, 1), a1 + hstepA, voffA);
            PG8_WAIT_L(8); PG8_BAR; PG8_WAIT_L(0); PG8_MMA(0, 0, At, B0); PG8_BAR; PG8_SCHED;
            PG8_LDB(B1, 0, 1); PG8_STAGE(PG8_SB(0, 0), b2, voffB);
            PG8_BAR; PG8_WAIT_L(0); PG8_MMA(0, 1, At, B1); PG8_BAR;
            PG8_LDA(At, 0, 1); PG8_STAGE(PG8_SA(0, 0), a2, voffA);
            PG8_BAR; PG8_WAIT_L(0); PG8_MMA(1, 0, At, B0); PG8_BAR; PG8_SCHED;
            PG8_STAGE(PG8_SB(0, 1), b2 + hstepB, voffB);
            PG8_WAIT_V(6); PG8_BAR; PG8_MMA(1, 1, At, B1); PG8_BAR;
            PG8_LDB(B0, 1, 0); PG8_SCHED; PG8_LDA(At, 1, 0); PG8_STAGE(PG8_SA(0, 1), a2 + hstepA, voffA);
            PG8_WAIT_L(8); PG8_BAR; PG8_WAIT_L(0); PG8_MMA(0, 0, At, B0); PG8_BAR; PG8_SCHED;
            PG8_LDB(B1, 1, 1); PG8_STAGE(PG8_SB(1, 0), b3, voffB);
            PG8_BAR; PG8_WAIT_L(0); PG8_MMA(0, 1, At, B1); PG8_BAR;
            PG8_LDA(At, 1, 1); PG8_STAGE(PG8_SA(1, 0), a3, voffA);
            PG8_BAR; PG8_WAIT_L(0); PG8_MMA(1, 0, At, B0); PG8_BAR; PG8_SCHED;
            PG8_STAGE(PG8_SB(1, 1), b3 + hstepB, voffB);
            PG8_WAIT_V(6); PG8_BAR; PG8_MMA(1, 1, At, B1); PG8_BAR;
            }
        }
        if constexpr (ALIGN_EPI) { if (wr == 0) PG8_BAR; }
        if constexpr (!Epi::AFTER_DRAIN) { E(acc, cur, wr, wc, fr, fq); S.done(cur); }
        if (!has_next) break;
#pragma unroll
        for (int a = 0; a < 2; ++a)
#pragma unroll
            for (int b = 0; b < 2; ++b)
#pragma unroll
                for (int m = 0; m < 4; ++m)
#pragma unroll
                    for (int n = 0; n < 2; ++n) acc[a][b][m][n] = (f32x4){0.f, 0.f, 0.f, 0.f};
        cur = nxt; cA = nA; cB = nB; ++ui;
        if constexpr (ALIGN_EPI) { if (wr == 1) PG8_BAR; }
    }
    PG8_WAIT_V(0);
    if constexpr (!ALIGN_EPI) { if (wr == 0) PG8_BAR; }
    PG8_BAR;
    if constexpr (Epi::AFTER_DRAIN) { E.fused(acc, cur, wr, wc, fr, fq, lds, wid, lane); S.done(cur); }
#undef PG8_SA
#undef PG8_SB
#undef PG8_STAGE
#undef PG8_LDA
#undef PG8_LDB
#undef PG8_MMA
#undef PG8_WAIT_V
#undef PG8_WAIT_L
#undef PG8_BAR
#undef PG8_SCHED
}
}

using pg8::bf16_t;
#define LAS __attribute__((address_space(3)))
#define GAS __attribute__((address_space(1)))
typedef float f32x4 __attribute__((ext_vector_type(4)));
typedef float f32x16 __attribute__((ext_vector_type(16)));
typedef short bf16x8 __attribute__((ext_vector_type(8)));
typedef short s16x4 __attribute__((ext_vector_type(4)));
typedef unsigned u32x4 __attribute__((ext_vector_type(4)));
typedef unsigned u32x2 __attribute__((ext_vector_type(2)));

constexpr int T_ = 4112, NB = 8, M_ = NB * T_, MP = 33024, D_ = 1024, NTHR = 512, NWV = 8;
constexpr float EPS = 1e-6f;
constexpr float QSCALE = 0.10206207261596577f * 1.4426950408889634f;
constexpr size_t MiB = 1u << 20;
constexpr size_t WS_CTL = 0, CTL_BYTES = 32768, WS_SSQM = 7 * MiB + 512 * 1024;
constexpr size_t WS_M = 10 * MiB;
constexpr size_t WS_SSQS = 75 * MiB;
constexpr size_t WS_COS = 1 * MiB, WS_SIN = 1 * MiB + 512 * 1024;
constexpr size_t WS_RSTDH = 2 * MiB, WS_RSTDQ = 2 * MiB + 256 * 1024, WS_RSTDKV = 2 * MiB + 512 * 1024;
constexpr size_t WS_DT = 3 * MiB, WS_KR = 5 * MiB + 256 * 1024, WS_SL = 3 * MiB, WS_SB = 4 * MiB + 512 * 1024;
constexpr size_t WS_H = 10 * MiB, WS_HB = 139 * MiB, WS_R = 203 * MiB + 512 * 1024;
constexpr size_t R_AB = 0, R_LAT = 129 * MiB, R_KV = 177 * MiB + 512 * 1024;
constexpr size_t R_U = 0;
constexpr size_t R_X = 0, R_G = 81 * MiB, R_XR = 162 * MiB;
constexpr size_t WS_NEED = WS_R + R_KV + 129 * MiB;
constexpr size_t WS_W = 80 * MiB;
constexpr size_t DO_Q = 30 * MiB;
constexpr size_t WS_PART = 112 * MiB;
constexpr size_t W_IN = 0, W_Q = 6 * MiB + 512 * 1024, W_KV = 7 * MiB + 640 * 1024, W_O = 8 * MiB + 640 * 1024, W_UP = 12 * MiB + 640 * 1024, W_DN = 20 * MiB + 640 * 1024;
constexpr size_t W_XY = 0, W_AI = 5 * MiB, W_RO = 5 * MiB + 640 * 1024;
constexpr int LDS_BYTES = 147456, LDS_CTL = 147200;

__device__ __forceinline__ unsigned xcc_id_() { return (unsigned)__builtin_amdgcn_s_getreg((3 << 11) | 20) & 0xFu; }
struct Params { const float* in[30]; float* out; unsigned char* ws; };
typedef const __attribute__((address_space(4))) unsigned char* PTAB;
__device__ __forceinline__ void* ldptr(PTAB kp, int k) { unsigned long long v = *(volatile const __attribute__((address_space(4))) unsigned long long*)(kp + 8 * k); asm volatile("" : "+s"(v)); return (void*)v; }
#define INP(k) ((const float*)ldptr(ptab, (k)))
#define OUTB ((unsigned char*)ldptr(ptab, 30))
#define WSP ((unsigned char*)ldptr(ptab, 31))

__device__ __forceinline__ float bflo(unsigned u) { return __uint_as_float(u << 16); }
__device__ __forceinline__ float bfhi(unsigned u) { return __uint_as_float(u & 0xffff0000u); }
__device__ __forceinline__ float bf1(bf16_t b) { return __uint_as_float((unsigned)b << 16); }
__device__ __forceinline__ unsigned pk2(float lo, float hi) {
    typedef float f2_t __attribute__((ext_vector_type(2))); typedef __bf16 b2_t __attribute__((ext_vector_type(2)));
    f2_t v = {lo, hi}; b2_t b = __builtin_convertvector(v, b2_t); return __builtin_bit_cast(unsigned, b); }
__device__ __forceinline__ float sigmoidf_(float x) { return __builtin_amdgcn_rcpf(1.0f + __expf(-x)); }
__device__ __forceinline__ float siluf_(float x) { return x * sigmoidf_(x); }
__device__ __forceinline__ float softplusf_(float x) { return x > 20.f ? x : __logf(1.0f + __expf(x)); }
__device__ __forceinline__ float gelu_tanh(float x) { const float y = 1.5957691216057308f * (x + 0.044715f * x * x * x); return x * __builtin_amdgcn_rcpf(1.0f + __expf(-y)); }
__device__ __forceinline__ float wave_sum(float v) {
#pragma unroll
    for (int o = 1; o < 64; o <<= 1) v += __shfl_xor(v, o);
    return v;
}
template <int CTRL> __device__ __forceinline__ float dpp_f(float v) { return __int_as_float(__builtin_amdgcn_update_dpp(0, __float_as_int(v), CTRL, 0xF, 0xF, true)); }
__device__ __forceinline__ float sum16(float v) { v += dpp_f<0xB1>(v); v += dpp_f<0x4E>(v); v += dpp_f<0x141>(v); v += dpp_f<0x140>(v); return v; }
__device__ __forceinline__ float sum8(float v) { v += dpp_f<0xB1>(v); v += dpp_f<0x4E>(v); v += dpp_f<0x141>(v); return v; }

enum { EP_IN = 0, EP_Q, EP_KV, EP_M, EP_UP, EP_XY, EP_AI, EP_PART };
template <int MODE> struct Epi {
    static constexpr bool PERM = true, AFTER_DRAIN = false;
    const float* rs; bf16_t* o0; bf16_t* o1; bf16_t* o2; float* ssq; const float* c0; const float* c1; const float* c2; const bf16_t* xr;
    __device__ __forceinline__ void operator()(const f32x4 (&acc)[2][2][4][2], const pg8::Unit& u, int wr, int wc, int fr, int fq) const {
        const int cw = wc * 32 + 8 * fq;
        float ai_ba[8], ai_bi[8], ai_sp[8];
        if constexpr (MODE == EP_AI) {
            const int ch = u.pn * 128 + cw;
#pragma unroll
            for (int e = 0; e < 8; ++e) { ai_ba[e] = *(const GAS float*)(c0 + ch + e); ai_bi[e] = *(const GAS float*)(c1 + ch + e); ai_sp[e] = -8.0f * softplusf_(-*(const GAS float*)(c2 + ch + e)); }
        }
        float scv[8];
        if constexpr (MODE == EP_IN || MODE == EP_KV || MODE == EP_UP || MODE == EP_XY || MODE == EP_Q) {
#pragma unroll
            for (int k = 0; k < 8; ++k) scv[k] = *(const GAS float*)(rs + u.pm * 256 + (k >> 2) * 128 + wr * 64 + (k & 3) * 16 + fr);
        }
#pragma unroll
        for (int ai = 0; ai < 2; ++ai) {
            u32x4 ai_xv[4];
            if constexpr (MODE == EP_AI) {
#pragma unroll
                for (int k = 0; k < 4; ++k) ai_xv[k] = *(const GAS u32x4*)(xr + (size_t)(u.pm * 256 + ai * 128 + wr * 64 + k * 16 + fr) * 1280 + u.pn * 128 + cw);
            }
#pragma unroll
            for (int m = 0; m < 4; ++m) {
                const int row = u.pm * 256 + ai * 128 + wr * 64 + m * 16 + fr;
                if constexpr (MODE == EP_PART) {
                    if (ai == 0) { GAS float* pp = (GAS float*)c0 + ((size_t)((u.pn >> 2) * 128 + wr * 64 + m * 16 + fr)) * 1024 + (u.pn & 3) * 256 + cw;
#pragma unroll
                        for (int bj = 0; bj < 2; ++bj) { *(GAS f32x4*)(pp + bj * 128) = acc[ai][bj][m][0]; *(GAS f32x4*)(pp + bj * 128 + 4) = acc[ai][bj][m][1]; } }
                } else
                if constexpr (MODE == EP_AI) {
                    const int ch = u.pn * 128 + cw;
                    const u32x4 xv = ai_xv[m];
                    const float xf[8] = {bflo(xv.x), bfhi(xv.x), bflo(xv.y), bfhi(xv.y), bflo(xv.z), bfhi(xv.z), bflo(xv.w), bfhi(xv.w)};
                    float la[8], uu[8];
#pragma unroll
                    for (int e = 0; e < 8; ++e) {
                        const float rp = acc[ai][0][m][e >> 2][e & 3] + ai_ba[e], ip = acc[ai][1][m][e >> 2][e & 3] + ai_bi[e];
                        const float r = sigmoidf_(rp), ig = sigmoidf_(ip);
                        const float l = r * ai_sp[e];
                        la[e] = l; uu[e] = __builtin_amdgcn_sqrtf(fmaxf(1.0f - __expf(2.0f * l), 0.f)) * (ig * xf[e]);
                    }
                    u32x4 w; w.x = pk2(la[0], la[1]); w.y = pk2(la[2], la[3]); w.z = pk2(la[4], la[5]); w.w = pk2(la[6], la[7]);
                    *(GAS u32x4*)(o0 + (size_t)row * 1280 + ch) = w;
                    w.x = pk2(uu[0], uu[1]); w.y = pk2(uu[2], uu[3]); w.z = pk2(uu[4], uu[5]); w.w = pk2(uu[6], uu[7]);
                    *(GAS u32x4*)(o1 + (size_t)row * 1280 + ch) = w;
                } else {
                    float sc = 1.0f;
                    if constexpr (MODE == EP_IN || MODE == EP_KV || MODE == EP_UP || MODE == EP_XY) sc = scv[ai * 4 + m];
                    if constexpr (MODE == EP_Q) sc = scv[ai * 4 + m] * QSCALE;
                    float sq = 0.f;
#pragma unroll
                    for (int bj = 0; bj < 2; ++bj) {
                        f32x4 v0 = acc[ai][bj][m][0] * sc, v1 = acc[ai][bj][m][1] * sc;
                        const int col = u.pn * 256 + bj * 128 + cw;
                        bf16_t* dst;
                        if constexpr (MODE == EP_IN) {
                            if (u.pn < 4) dst = o0 + (size_t)row * 2048 + col; else if (u.pn < 10) dst = o1 + (size_t)row * 1536 + (col - 1024); else dst = o2 + (size_t)row * 768 + (col - 2560);
                        } else if constexpr (MODE == EP_Q) {
                            dst = o0 + (size_t)row * 1536 + col;
                            const int d = col % 96;
                            if (d >= 64) {
                                const int t = row % T_, i0 = (d - 64) >> 1;
                                const f32x4 c = *(const GAS f32x4*)(c0 + t * 16 + i0), s = *(const GAS f32x4*)(c1 + t * 16 + i0);
                                const f32x4 a0 = v0, a1 = v1;
                                v0[0] = a0[0] * c[0] - a0[1] * s[0]; v0[1] = a0[1] * c[0] + a0[0] * s[0];
                                v0[2] = a0[2] * c[1] - a0[3] * s[1]; v0[3] = a0[3] * c[1] + a0[2] * s[1];
                                v1[0] = a1[0] * c[2] - a1[1] * s[2]; v1[1] = a1[1] * c[2] + a1[0] * s[2];
                                v1[2] = a1[2] * c[3] - a1[3] * s[3]; v1[3] = a1[3] * c[3] + a1[2] * s[3];
                            }
                        } else if constexpr (MODE == EP_KV) { dst = o0 + (size_t)row * 2048 + col;
                        } else if constexpr (MODE == EP_M) { dst = o0 + (size_t)row * 1024 + col;
                            sq += (v0[0] * v0[0] + v0[1] * v0[1]) + (v0[2] * v0[2] + v0[3] * v0[3]) + (v1[0] * v1[0] + v1[1] * v1[1]) + (v1[2] * v1[2] + v1[3] * v1[3]);
                        } else if constexpr (MODE == EP_UP) { dst = o0 + (size_t)row * 4096 + col;
#pragma unroll
                            for (int e = 0; e < 4; ++e) { const float a = fmaxf(v0[e], 0.f), b = fmaxf(v1[e], 0.f); v0[e] = a * a; v1[e] = b * b; }
                        } else {
                            if (u.pn < 5) dst = o0 + (size_t)row * 1280 + col;
                            else { dst = o1 + (size_t)row * 1280 + (col - 1280);
#pragma unroll
                                for (int e = 0; e < 4; ++e) { v0[e] = gelu_tanh(v0[e]); v1[e] = gelu_tanh(v1[e]); } }
                        }
                        u32x4 w; w.x = pk2(v0[0], v0[1]); w.y = pk2(v0[2], v0[3]); w.z = pk2(v1[0], v1[1]); w.w = pk2(v1[2], v1[3]);
                        if constexpr (MODE == EP_UP) __builtin_nontemporal_store(w, (GAS u32x4*)dst);
                        else *(GAS u32x4*)dst = w;
                    }
                    if constexpr (MODE == EP_M) {
                        sq += __shfl_xor(sq, 16); sq += __shfl_xor(sq, 32);
                        if (fq == 0) *(GAS float*)(ssq + (size_t)row * 16 + u.pn * 4 + wc) = sq;
                    }
                }
            }
        }
    }
};

struct TailOrder {
    int nN, G, c, pm;
    __device__ bool next(int i, pg8::Unit& u) const { const int pn = i * G + c; if (pn >= nN) return false; u.pm = pm; u.pn = pn; return true; }
    __device__ __forceinline__ void a_ready(const pg8::Unit&) const {}
    __device__ __forceinline__ void done(const pg8::Unit&) const {}
};
template <int MODE, int PART = 0> __device__ __forceinline__ void run_gemm(int wv_, LAS unsigned char* lds, const bf16_t* A, int lda, int a_pn, const bf16_t* Bt, int N, int K, const Epi<MODE>& E) {
    pg8::Gemm g{A, Bt, MP, N, K, lda, K, a_pn, MP / 256 - 1, 1 << 20, 0};
    int bid_ = __builtin_amdgcn_readfirstlane((int)*(volatile LAS unsigned*)(lds + LDS_CTL + 128)), gdim_ = (int)gridDim.x; asm volatile("" : "+s"(bid_), "+s"(gdim_));
    if constexpr (PART == 2) { TailOrder S{N / 256, gdim_, bid_, MP / 256 - 1}; pg8::gemm_phase<Epi<MODE>, TailOrder, true, true>(wv_, lds, g, S, E); }
    else { pg8::StaticOrder S; S.init(PART == 1 ? MP - 256 : MP, N, gdim_, bid_); pg8::gemm_phase<Epi<MODE>, pg8::StaticOrder, true, true>(wv_, lds, g, S, E); }
}

template <int MODE> __device__ __forceinline__ void run_gemm_tail(int wv_, LAS unsigned char* lds, const bf16_t* A, int lda, const bf16_t* Bt, int ldb, int ksz, int nks, const Epi<MODE>& E) {
    pg8::Gemm g{A, Bt, MP, 1024, ksz, lda, ldb, 0, MP / 256 - 1, 4, ksz * 2};
    int bid_ = __builtin_amdgcn_readfirstlane((int)*(volatile LAS unsigned*)(lds + LDS_CTL + 128)), gdim_ = (int)gridDim.x; asm volatile("" : "+s"(bid_), "+s"(gdim_));
    TailOrder S{4 * nks, gdim_, bid_, MP / 256 - 1}; pg8::gemm_phase<Epi<MODE>, TailOrder, true, true>(wv_, lds, g, S, E);
}

__device__ __forceinline__ int cmap(int kind, int n) {
    if (kind == 0) return n;
    if (kind == 1) {
        if (n < 2560) return n;
        const int j = n - 2560;
        if (j < 384) return 2576 + j;
        if (j < 640) return 2960 + (j - 384);
        if (j < 672) { const int i = (j - 640) >> 1; return (j & 1) ? 3216 + 16 + i : 3216 + i; }
        if (j < 688) return 2560 + (j - 672);
        return -1;
    }
    const int h = n / 96, d = n % 96;
    if (d < 64) return n;
    const int i = (d - 64) >> 1;
    return h * 96 + 64 + ((d & 1) ? 16 + i : i);
}
__device__ __forceinline__ void cvt_item(const float* W, int K, int Ns, bf16_t* WT, int row_off, int Nd, int kind, const float* g, int glim, LAS float* scr, int item, int lane) {
    const int nblk = Nd / 32, kb = item / nblk, nb = item % nblk, k0 = 64 * kb, n0 = 32 * nb;
    const int sc = cmap(kind, n0 + (lane & 31));
    {
        const int scc = sc >= 0 ? sc : 0; float wv32[32], gv32[32];
        const GAS float* wp = (const GAS float*)W + (size_t)(k0 + (lane >> 5)) * Ns + scc;
#pragma unroll
        for (int i = 0; i < 32; ++i) wv32[i] = wp[(size_t)(2 * i) * Ns];
#pragma unroll
        for (int i = 0; i < 32; ++i) { const int kk = k0 + 2 * i + (lane >> 5); gv32[i] = (g && kk < glim) ? *(const GAS float*)(g + kk) : 1.0f; }
#pragma unroll
        for (int i = 0; i < 32; ++i) { const int kk = 2 * i + (lane >> 5); scr[kk * 33 + (lane & 31)] = sc >= 0 ? wv32[i] * gv32[i] : 0.f; }
    }
    asm volatile("s_waitcnt lgkmcnt(0)" ::: "memory");
    const int c = lane & 7;
#pragma unroll
    for (int j = 0; j < 4; ++j) { const int n = (lane >> 3) + 8 * j; const LAS float* s = scr + (8 * c) * 33 + n;
        u32x4 o; o.x = pk2(s[0 * 33], s[1 * 33]); o.y = pk2(s[2 * 33], s[3 * 33]); o.z = pk2(s[4 * 33], s[5 * 33]); o.w = pk2(s[6 * 33], s[7 * 33]);
        *(u32x4*)(WT + (size_t)(row_off + n0 + n) * K + k0 + 8 * c) = o; }
    asm volatile("s_waitcnt lgkmcnt(0)" ::: "memory");
}
__device__ __forceinline__ void convert_layer(PTAB ptab, int wv_, int L, LAS unsigned char* lds) {
    const int lane = tid_opaque() & 63, wave = tid_opaque() >> 6;
    LAS float* scr = (LAS float*)(lds + wave * 16384);
    const int NGW = gridDim.x * NWV; int it = blockIdx.x * NWV + wave;
    bf16_t* W = (bf16_t*)(WSP + WS_W);
#define JOB(Wp, K, Ns, dstoff, roff, Nd, kind, g, glim) { const int ni_ = ((K) / 64) * ((Nd) / 32); for (; it < ni_; it += NGW) cvt_item((Wp), (K), (Ns), (bf16_t*)((unsigned char*)W + (dstoff)), (roff), (Nd), (kind), (g), (glim), scr, it, lane); it -= ni_; }
    if ((L & 1) == 0) {
        const int e = L >> 1;
        JOB(INP(8) + (size_t)e * 1024 * 3248, 1024, 3248, W_IN, 0, 3328, 1, INP(2) + L * 1024, 1024);
        JOB(INP(16) + (size_t)e * 384 * 1536, 384, 1536, W_Q, 0, 1536, 2, INP(15) + e * 384, 384);
        JOB(INP(18) + (size_t)e * 256 * 2048, 256, 2048, W_KV, 0, 2048, 0, INP(17) + e * 256, 256);
        JOB(INP(19) + (size_t)e * 2048 * 1024, 2048, 1024, W_O, 0, 1024, 0, INP(14) + e * 1024, 1024);
    } else {
        const int o = L >> 1;
        JOB(INP(20) + (size_t)o * 1024 * 1280, 1024, 1280, W_XY, 0, 1280, 0, INP(2) + L * 1024, 1024);
        JOB(INP(21) + (size_t)o * 1024 * 1280, 1024, 1280, W_XY, 1280, 1280, 0, INP(2) + L * 1024, 1024);
        for (int blk = 0; blk < 10; ++blk) {
            JOB(INP(24) + (size_t)(o * 10 + blk) * 128 * 128, 128, 128, W_AI, blk * 256, 128, 0, (const float*)nullptr, 0);
            JOB(INP(26) + (size_t)(o * 10 + blk) * 128 * 128, 128, 128, W_AI, blk * 256 + 128, 128, 0, (const float*)nullptr, 0);
        }
        JOB(INP(29) + (size_t)o * 1280 * 1024, 1280, 1024, W_RO, 0, 1024, 0, (const float*)nullptr, 0);
    }
    JOB(INP(6) + (size_t)L * 1024 * 4096, 1024, 4096, W_UP, 0, 4096, 0, INP(4) + L * 1024, 1024);
    JOB(INP(7) + (size_t)L * 4096 * 1024, 4096, 1024, W_DN, 0, 1024, 0, (const float*)nullptr, 0);
#undef JOB
}

__device__ __forceinline__ void setup_rows(PTAB ptab, int wv_) {
    const int lane = tid_opaque() & 63, gw = blockIdx.x * NWV + (tid_opaque() >> 6), NGW = gridDim.x * NWV;
    bf16_t* HB = (bf16_t*)(WSP + WS_HB); float* rstd = (float*)(WSP + WS_RSTDH);
    for (int row = gw; row < MP; row += NGW) {
        f32x4 v[4]; float s = 0.f;
        const float* src = nullptr;
        if (row < M_) { const int b = row / T_, t = row % T_; src = t < 16 ? INP(1) + (size_t)t * D_ : INP(0) + ((size_t)b * 4096 + (t - 16)) * D_; }
#pragma unroll
        for (int j = 0; j < 4; ++j) { v[j] = src ? *(const f32x4*)(src + 4 * lane + 256 * j) : (f32x4){0.f, 0.f, 0.f, 0.f}; s += (v[j][0] * v[j][0] + v[j][1] * v[j][1]) + (v[j][2] * v[j][2] + v[j][3] * v[j][3]); }
        s = wave_sum(s);
#pragma unroll
        for (int j = 0; j < 4; ++j) {
            u32x2 w; w.x = pk2(v[j][0], v[j][1]); w.y = pk2(v[j][2], v[j][3]); *(u32x2*)(HB + (size_t)row * D_ + 4 * lane + 256 * j) = w; }
        if (lane == 0) rstd[row] = __builtin_amdgcn_rsqf(s * (1.0f / D_) + EPS);
    }
    float* ct = (float*)(WSP + WS_COS); float* st = (float*)(WSP + WS_SIN);
    for (int i = blockIdx.x * NTHR + tid_opaque(); i < T_ * 16; i += gridDim.x * NTHR) {
        const int t = i >> 4, k = i & 15; const float inv = powf(10000.0f, -(float)(2 * k) / 32.0f); const float ang = (float)t * inv;
        ct[i] = cosf(ang); st[i] = sinf(ang);
    }
}
__device__ __forceinline__ void resnorm_phase(PTAB ptab, int wv_, LAS unsigned char* lds, const float* gpost, bool last, int r0, int r1, int cu_lo, bool dry = false) {
    const int vcu_ = __builtin_amdgcn_readfirstlane((int)*(volatile LAS unsigned*)(lds + LDS_CTL + 128));
    if (vcu_ < cu_lo) return;
    const int lane = tid_opaque() & 63, gw = (vcu_ - cu_lo) * NWV + (tid_opaque() >> 6), NGW = ((int)gridDim.x - cu_lo) * NWV;
    const GAS bf16_t* MB = (const GAS bf16_t*)(WSP + WS_M); GAS bf16_t* HB = (GAS bf16_t*)(WSP + WS_HB); GAS float* rstd = (GAS float*)(WSP + WS_RSTDH); const GAS float* ssq = (const GAS float*)(WSP + WS_SSQM);
    const GAS float* gp = (const GAS float*)gpost; GAS float* outp = (GAS float*)OUTB;
    f32x4 g[4];
#pragma unroll
    for (int j = 0; j < 4; ++j) g[j] = *(const GAS f32x4*)(gp + 4 * lane + 256 * j);
    constexpr int RB = 4;
    for (int row0 = r0 + gw; row0 < r1; row0 += RB * NGW) {
        u32x2 hb[RB][4], mb[RB][4]; float pq[RB];
#pragma unroll
        for (int q = 0; q < RB; ++q) { int row = row0 + q * NGW; row = row < r1 ? row : row0;
            pq[q] = lane < 16 ? ssq[(size_t)row * 16 + lane] : 0.f;
#pragma unroll
            for (int j = 0; j < 4; ++j) { const int c = 4 * lane + 256 * j; hb[q][j] = *(const GAS u32x2*)(HB + (size_t)row * D_ + c); mb[q][j] = *(const GAS u32x2*)(MB + (size_t)row * D_ + c); } }
#pragma unroll
        for (int q = 0; q < RB; ++q) { const int row = row0 + q * NGW;
            if (row < r1) {
                const float rm = __builtin_amdgcn_rsqf(wave_sum(pq[q]) * (1.0f / D_) + EPS);
                f32x4 v[4]; float sq = 0.f;
#pragma unroll
                for (int j = 0; j < 4; ++j) {
                    v[j][0] = bflo(hb[q][j].x) + bflo(mb[q][j].x) * rm * g[j][0]; v[j][1] = bfhi(hb[q][j].x) + bfhi(mb[q][j].x) * rm * g[j][1];
                    v[j][2] = bflo(hb[q][j].y) + bflo(mb[q][j].y) * rm * g[j][2]; v[j][3] = bfhi(hb[q][j].y) + bfhi(mb[q][j].y) * rm * g[j][3];
                    sq += (v[j][0] * v[j][0] + v[j][1] * v[j][1]) + (v[j][2] * v[j][2] + v[j][3] * v[j][3]); }
                sq = wave_sum(sq);
                if (dry) { if (sq == 12345.678f) rstd[row] = sq; }
                else if (!last) {
#pragma unroll
                    for (int j = 0; j < 4; ++j) { const int c = 4 * lane + 256 * j;
                        u32x2 w; w.x = pk2(v[j][0], v[j][1]); w.y = pk2(v[j][2], v[j][3]); *(GAS u32x2*)(HB + (size_t)row * D_ + c) = w; }
                    if (lane == 0) rstd[row] = __builtin_amdgcn_rsqf(sq * (1.0f / D_) + EPS);
                } else if (row < M_) {
                    const int b = row / T_, t = row % T_;
                    if (t >= 16) {
#pragma unroll
                        for (int j = 0; j < 4; ++j) *(GAS f32x4*)(outp + ((size_t)b * 4096 + (t - 16)) * D_ + 4 * lane + 256 * j) = v[j];
                    }
                }
            }
        }
    }
}
__device__ __forceinline__ void tail_reduce_resnorm(PTAB ptab, int wv_, const float* gpost, bool last, int nks) {
    const int lane = tid_opaque() & 63, gw = blockIdx.x * NWV + (tid_opaque() >> 6), NGW = gridDim.x * NWV;
    const GAS float* PART = (const GAS float*)(WSP + WS_PART); GAS bf16_t* HB = (GAS bf16_t*)(WSP + WS_HB); GAS float* rstd = (GAS float*)(WSP + WS_RSTDH);
    const GAS float* gp = (const GAS float*)gpost; GAS float* outp = (GAS float*)OUTB;
    for (int r = gw; r < 128; r += NGW) {
        const int row = MP - 256 + r;
        f32x4 m[4]; u32x2 hb[4]; f32x4 g[4];
#pragma unroll
        for (int j = 0; j < 4; ++j) { const int c = 4 * lane + 256 * j; m[j] = *(const GAS f32x4*)(PART + (size_t)r * 1024 + c); hb[j] = *(const GAS u32x2*)(HB + (size_t)row * D_ + c); g[j] = *(const GAS f32x4*)(gp + c); }
        for (int ks = 1; ks < nks; ++ks) {
#pragma unroll
            for (int j = 0; j < 4; ++j) m[j] += *(const GAS f32x4*)(PART + ((size_t)ks * 128 + r) * 1024 + 4 * lane + 256 * j); }
        float pq = 0.f;
#pragma unroll
        for (int j = 0; j < 4; ++j) pq += (m[j][0] * m[j][0] + m[j][1] * m[j][1]) + (m[j][2] * m[j][2] + m[j][3] * m[j][3]);
        const float rm = __builtin_amdgcn_rsqf(wave_sum(pq) * (1.0f / D_) + EPS);
        f32x4 v[4]; float sq = 0.f;
#pragma unroll
        for (int j = 0; j < 4; ++j) {
            v[j][0] = bflo(hb[j].x) + m[j][0] * rm * g[j][0]; v[j][1] = bfhi(hb[j].x) + m[j][1] * rm * g[j][1]; v[j][2] = bflo(hb[j].y) + m[j][2] * rm * g[j][2]; v[j][3] = bfhi(hb[j].y) + m[j][3] * rm * g[j][3];
            sq += (v[j][0] * v[j][0] + v[j][1] * v[j][1]) + (v[j][2] * v[j][2] + v[j][3] * v[j][3]); }
        sq = wave_sum(sq);
        if (!last) {
#pragma unroll
            for (int j = 0; j < 4; ++j) { u32x2 w; w.x = pk2(v[j][0], v[j][1]); w.y = pk2(v[j][2], v[j][3]); *(GAS u32x2*)(HB + (size_t)row * D_ + 4 * lane + 256 * j) = w; }
            if (lane == 0) rstd[row] = __builtin_amdgcn_rsqf(sq * (1.0f / D_) + EPS);
        } else {
            const int b = row / T_, t = row % T_;
#pragma unroll
            for (int j = 0; j < 4; ++j) *(GAS f32x4*)(outp + ((size_t)b * 4096 + (t - 16)) * D_ + 4 * lane + 256 * j) = v[j];
        }
    }
}
template <bool SILU> __device__ __forceinline__ void conv_pass(int wv_, const bf16_t* Xg, int ncols, const float* cwg, const float* cbg, bf16_t* Og) {
    const GAS bf16_t* X = (const GAS bf16_t*)Xg; GAS bf16_t* O = (GAS bf16_t*)Og; const GAS float* cw = (const GAS float*)cwg; const GAS float* cb = (const GAS float*)cbg;
    const int nchunk = ncols >> 3; constexpr int RUN = 48;
    for (int it = blockIdx.x * NTHR + tid_opaque(); it < nchunk * (MP / RUN); it += gridDim.x * NTHR) {
        const int c = (it % nchunk) * 8, r0 = (it / nchunk) * RUN;
        float w[4][8], bia[8];
#pragma unroll
        for (int i = 0; i < 4; ++i) { const f32x4 a = *(const GAS f32x4*)(cw + i * ncols + c), b = *(const GAS f32x4*)(cw + i * ncols + c + 4);
            w[i][0] = a[0]; w[i][1] = a[1]; w[i][2] = a[2]; w[i][3] = a[3]; w[i][4] = b[0]; w[i][5] = b[1]; w[i][6] = b[2]; w[i][7] = b[3]; }
        { const f32x4 a = *(const GAS f32x4*)(cb + c), b = *(const GAS f32x4*)(cb + c + 4); bia[0] = a[0]; bia[1] = a[1]; bia[2] = a[2]; bia[3] = a[3]; bia[4] = b[0]; bia[5] = b[1]; bia[6] = b[2]; bia[7] = b[3]; }
        u32x4 x1, x2, x3;
        { const int ra = r0 - 1 > 0 ? r0 - 1 : 0, rb = r0 - 2 > 0 ? r0 - 2 : 0, rc = r0 - 3 > 0 ? r0 - 3 : 0;
          x1 = *(const GAS u32x4*)(X + (size_t)ra * ncols + c); x2 = *(const GAS u32x4*)(X + (size_t)rb * ncols + c); x3 = *(const GAS u32x4*)(X + (size_t)rc * ncols + c); }
        for (int rr = 0; rr < RUN; rr += 4) {
            u32x4 xn[4];
#pragma unroll
            for (int k = 0; k < 4; ++k) xn[k] = *(const GAS u32x4*)(X + (size_t)(r0 + rr + k) * ncols + c);
#pragma unroll
            for (int k = 0; k < 4; ++k) {
                const int row = r0 + rr + k, t = row % T_;
                const float m1 = t >= 1 ? 1.f : 0.f, m2 = t >= 2 ? 1.f : 0.f, m3 = t >= 3 ? 1.f : 0.f;
                const u32x4 x0 = xn[k]; float a[8];
#define CV_(e, f0, f1, f2, f3) a[e] = bia[e] + w[3][e] * (f0) + m1 * (w[2][e] * (f1)) + m2 * (w[1][e] * (f2)) + m3 * (w[0][e] * (f3))
                CV_(0, bflo(x0.x), bflo(x1.x), bflo(x2.x), bflo(x3.x)); CV_(1, bfhi(x0.x), bfhi(x1.x), bfhi(x2.x), bfhi(x3.x));
                CV_(2, bflo(x0.y), bflo(x1.y), bflo(x2.y), bflo(x3.y)); CV_(3, bfhi(x0.y), bfhi(x1.y), bfhi(x2.y), bfhi(x3.y));
                CV_(4, bflo(x0.z), bflo(x1.z), bflo(x2.z), bflo(x3.z)); CV_(5, bfhi(x0.z), bfhi(x1.z), bfhi(x2.z), bfhi(x3.z));
                CV_(6, bflo(x0.w), bflo(x1.w), bflo(x2.w), bflo(x3.w)); CV_(7, bfhi(x0.w), bfhi(x1.w), bfhi(x2.w), bfhi(x3.w));
#undef CV_
                if (SILU) {
#pragma unroll
                    for (int e2 = 0; e2 < 8; ++e2) a[e2] = siluf_(a[e2]); }
                u32x4 o; o.x = pk2(a[0], a[1]); o.y = pk2(a[2], a[3]); o.z = pk2(a[4], a[5]); o.w = pk2(a[6], a[7]);
                *(GAS u32x4*)(O + (size_t)row * ncols + c) = o;
                x3 = x2; x2 = x1; x1 = x0;
            }
        }
    }
}
__device__ __forceinline__ void prep_phase(PTAB ptab, int wv_, int e) {
    const int lane = tid_opaque() & 63, gw = blockIdx.x * NWV + (tid_opaque() >> 6), NGW = gridDim.x * NWV;
    const bf16_t* LAT = (const bf16_t*)(WSP + WS_R + R_LAT);
    float* rq = (float*)(WSP + WS_RSTDQ); float* rkv = (float*)(WSP + WS_RSTDKV); float* DT = (float*)(WSP + WS_DT); bf16_t* KR = (bf16_t*)(WSP + WS_KR);
    const float* ct = (const float*)(WSP + WS_COS); const float* st = (const float*)(WSP + WS_SIN);
    const float* dtb = INP(11) + e * 16;
    for (int row0 = gw; row0 < MP; row0 += 4 * NGW) {
        unsigned wq[4][3], wk[4][2], wx[4];
#pragma unroll
        for (int q = 0; q < 4; ++q) { int row = row0 + q * NGW; row = row < MP ? row : row0; const GAS bf16_t* lr = (const GAS bf16_t*)LAT + (size_t)row * 768;
#pragma unroll
            for (int j = 0; j < 3; ++j) wq[q][j] = *(const GAS unsigned*)(lr + 2 * lane + 128 * j);
#pragma unroll
            for (int j = 0; j < 2; ++j) wk[q][j] = *(const GAS unsigned*)(lr + 384 + 2 * lane + 128 * j);
            wx[q] = *(const GAS unsigned*)(lr + 640 + 2 * (lane & 31)); }
#pragma unroll
        for (int q = 0; q < 4; ++q) { const int row = row0 + q * NGW;
            if (row < MP) {
                float sq = 0.f, sk = 0.f;
#pragma unroll
                for (int j = 0; j < 3; ++j) { const float a = bflo(wq[q][j]), b = bfhi(wq[q][j]); sq += a * a + b * b; }
#pragma unroll
                for (int j = 0; j < 2; ++j) { const float a = bflo(wk[q][j]), b = bfhi(wk[q][j]); sk += a * a + b * b; }
                sq = wave_sum(sq); sk = wave_sum(sk);
                if (lane == 0) { *(GAS float*)(rq + row) = __builtin_amdgcn_rsqf(sq * (1.0f / 384.f) + EPS); *(GAS float*)(rkv + row) = __builtin_amdgcn_rsqf(sk * (1.0f / 256.f) + EPS); }
                const int t = row % T_;
                if (lane < 16) { const float x1 = bflo(wx[q]), x2 = bfhi(wx[q]), c = *(const GAS float*)(ct + t * 16 + lane), sn = *(const GAS float*)(st + t * 16 + lane);
                    *(GAS unsigned*)(KR + (size_t)row * 32 + 2 * lane) = pk2(x1 * c - x2 * sn, x2 * c + x1 * sn); }
                else if (lane < 24) { const int h2 = 2 * (lane - 16);
                    *(GAS float*)(DT + (size_t)row * 16 + h2) = softplusf_(bflo(wx[q]) + *(const GAS float*)(dtb + h2)); *(GAS float*)(DT + (size_t)row * 16 + h2 + 1) = softplusf_(bfhi(wx[q]) + *(const GAS float*)(dtb + h2 + 1)); }
            }
        }
    }
    conv_pass<true>(wv_, (const bf16_t*)(WSP + WS_R + R_KV), 1536, INP(9) + (size_t)e * 4 * 1536, INP(10) + (size_t)e * 1536, (bf16_t*)(OUTB + DO_Q));
}
__device__ __forceinline__ void fix_phase(PTAB ptab, int wv_, bool dry = false) {
    const int lane = tid_opaque() & 63, gw = blockIdx.x * NWV + (tid_opaque() >> 6), NGW = gridDim.x * NWV;
    bf16_t* AB = (bf16_t*)(WSP + WS_R + R_AB); float* ssq = (float*)(WSP + WS_SSQS);
    for (int row0 = gw; row0 < MP; row0 += 4 * NGW) {
        float pq[4]; u32x4 v[4][2];
#pragma unroll
        for (int q = 0; q < 4; ++q) { int row = row0 + q * NGW; row = row < MP ? row : row0;
            pq[q] = lane < 32 ? *(const GAS float*)(ssq + (size_t)row * 32 + lane) : 0.f;
#pragma unroll
            for (int j = 0; j < 2; ++j) v[q][j] = *(const GAS u32x4*)(AB + (size_t)row * 2048 + 8 * lane + 512 * j); }
#pragma unroll
        for (int q = 0; q < 4; ++q) { const int row = row0 + q * NGW;
            if (row < MP) { const float rs = __builtin_amdgcn_rsqf(wave_sum(pq[q]) * (1.0f / 1024.f) + EPS);
#pragma unroll
                for (int j = 0; j < 2; ++j) { u32x4 w = v[q][j];
                    w.x = pk2(bflo(w.x) * rs, bfhi(w.x) * rs); w.y = pk2(bflo(w.y) * rs, bfhi(w.y) * rs); w.z = pk2(bflo(w.z) * rs, bfhi(w.z) * rs); w.w = pk2(bflo(w.w) * rs, bfhi(w.w) * rs);
                    if (!dry || w.x == 0x12345678u) *(GAS u32x4*)(AB + (size_t)row * 2048 + 8 * lane + 512 * j) = w; } }
        }
    }
}
__device__ __forceinline__ void rgconv_phase(PTAB ptab, int wv_, int o) {
    conv_pass<false>(wv_, (const bf16_t*)(WSP + WS_R + R_X), 1280, INP(22) + (size_t)o * 4 * 1280, INP(23) + (size_t)o * 1280, (bf16_t*)(WSP + WS_R + R_XR));
}
constexpr int SC_NC = 33;
__device__ __forceinline__ void scan_a_phase(PTAB ptab, int wv_) {
    const GAS bf16_t* LA = (const GAS bf16_t*)(WSP + WS_R + R_X); const GAS bf16_t* U = (const GAS bf16_t*)(OUTB + DO_Q);
    GAS float* SL = (GAS float*)(WSP + WS_SL); GAS float* SB = (GAS float*)(WSP + WS_SB);
    for (int it = blockIdx.x * NTHR + tid_opaque(); it < NB * SC_NC * 320; it += gridDim.x * NTHR) {
        const int c4 = (it % 320) * 4, bc = it / 320, ck = bc % SC_NC, b = bc / SC_NC;
        const int t0 = ck * 128, n = (T_ - t0) < 128 ? (T_ - t0) : 128;
        const size_t base = ((size_t)b * T_ + t0) * 1280 + c4;
        float h[4] = {0.f, 0.f, 0.f, 0.f}, sl[4] = {0.f, 0.f, 0.f, 0.f};
        for (int l0 = 0; l0 < n; l0 += 8) {
            u32x2 av[8], uv[8];
#pragma unroll
            for (int k = 0; k < 8; ++k) { av[k] = *(const GAS u32x2*)(LA + base + (size_t)(l0 + k) * 1280); uv[k] = *(const GAS u32x2*)(U + base + (size_t)(l0 + k) * 1280); }
#pragma unroll
            for (int k = 0; k < 8; ++k) { const float l0f = bflo(av[k].x), l1 = bfhi(av[k].x), l2 = bflo(av[k].y), l3 = bfhi(av[k].y);
                h[0] = __expf(l0f) * h[0] + bflo(uv[k].x); h[1] = __expf(l1) * h[1] + bfhi(uv[k].x); h[2] = __expf(l2) * h[2] + bflo(uv[k].y); h[3] = __expf(l3) * h[3] + bfhi(uv[k].y);
                sl[0] += l0f; sl[1] += l1; sl[2] += l2; sl[3] += l3; }
        }
        *(GAS f32x4*)(SL + (size_t)bc * 1280 + c4) = (f32x4){sl[0], sl[1], sl[2], sl[3]};
        *(GAS f32x4*)(SB + (size_t)bc * 1280 + c4) = (f32x4){h[0], h[1], h[2], h[3]};
    }
}
__device__ __forceinline__ void scan_c_phase(PTAB ptab, int wv_, bool dry = false) {
    const GAS bf16_t* LA = (const GAS bf16_t*)(WSP + WS_R + R_X); GAS bf16_t* U = (GAS bf16_t*)(OUTB + DO_Q); const GAS bf16_t* G = (const GAS bf16_t*)(WSP + WS_R + R_G);
    const GAS float* SL = (const GAS float*)(WSP + WS_SL); const GAS float* SB = (const GAS float*)(WSP + WS_SB);
    for (int it = blockIdx.x * NTHR + tid_opaque(); it < NB * SC_NC * 320; it += gridDim.x * NTHR) {
        const int c4 = (it % 320) * 4, bc = it / 320, ck = bc % SC_NC, b = bc / SC_NC;
        const int t0 = ck * 128, n = (T_ - t0) < 128 ? (T_ - t0) : 128;
        const size_t base = ((size_t)b * T_ + t0) * 1280 + c4;
        float h[4] = {0.f, 0.f, 0.f, 0.f};
        for (int j0 = 0; j0 < ck; j0 += 4) {
            f32x4 sl[4], sb[4];
#pragma unroll
            for (int k = 0; k < 4; ++k) { const int j = (j0 + k) < ck ? (j0 + k) : (ck - 1); sl[k] = *(const GAS f32x4*)(SL + (size_t)(b * SC_NC + j) * 1280 + c4); sb[k] = *(const GAS f32x4*)(SB + (size_t)(b * SC_NC + j) * 1280 + c4); }
#pragma unroll
            for (int k = 0; k < 4; ++k) if (j0 + k < ck) { h[0] = __expf(sl[k][0]) * h[0] + sb[k][0]; h[1] = __expf(sl[k][1]) * h[1] + sb[k][1]; h[2] = __expf(sl[k][2]) * h[2] + sb[k][2]; h[3] = __expf(sl[k][3]) * h[3] + sb[k][3]; }
        }
        for (int l0 = 0; l0 < n; l0 += 8) {
            u32x2 av[8], uv[8], gv[8];
#pragma unroll
            for (int k = 0; k < 8; ++k) { const size_t o = base + (size_t)(l0 + k) * 1280; av[k] = *(const GAS u32x2*)(LA + o); uv[k] = *(const GAS u32x2*)(U + o); gv[k] = *(const GAS u32x2*)(G + o); }
#pragma unroll
            for (int k = 0; k < 8; ++k) {
                h[0] = __expf(bflo(av[k].x)) * h[0] + bflo(uv[k].x); h[1] = __expf(bfhi(av[k].x)) * h[1] + bfhi(uv[k].x); h[2] = __expf(bflo(av[k].y)) * h[2] + bflo(uv[k].y); h[3] = __expf(bfhi(av[k].y)) * h[3] + bfhi(uv[k].y);
                u32x2 w; w.x = pk2(h[0] * bflo(gv[k].x), h[1] * bfhi(gv[k].x)); w.y = pk2(h[2] * bflo(gv[k].y), h[3] * bfhi(gv[k].y));
                if (!dry || w.x == 0x12345678u) *(GAS u32x2*)(U + base + (size_t)(l0 + k) * 1280) = w; }
        }
    }
}

typedef short v4i16_t __attribute__((ext_vector_type(4)));
__device__ __forceinline__ s16x4 vtr(const LAS unsigned char* p) { return __builtin_bit_cast(s16x4, __builtin_amdgcn_ds_read_tr16_b64_v4i16((LAS v4i16_t*)p)); }
#define MFMA32(a, b, c) __builtin_amdgcn_mfma_f32_32x32x16_bf16((a), (b), (c), 0, 0, 0)
constexpr int SD_BP = 272, SD_XP = 192;
constexpr int SD_B = 0, SD_C = 128 * SD_BP, SD_X = 2 * 128 * SD_BP, SD_XS = SD_X + 128 * SD_XP, SD_S = SD_XS + 128 * SD_XP, SD_ACS = SD_S + 64 * SD_BP, SD_DT = SD_ACS + 512, SD_F = SD_DT + 512, SD_END = SD_F + 512;
static_assert(SD_END <= LDS_CTL, "SSD LDS map");
__device__ __forceinline__ void ssd_phase(PTAB ptab, int wv_, int e, LAS unsigned char* lds, bool dry = false) {
    const int tid = tid_opaque(), lane = tid & 63, wid = __builtin_amdgcn_readfirstlane(tid >> 6), r = lane & 31, hh = lane >> 5;
    const int lb = wid & 3, pb = wid >> 2, q4 = (lane & 15) >> 2, p4 = lane & 3, blk = (lane >> 4) & 1;
    const bf16_t* XC = (const bf16_t*)(OUTB + DO_Q); const float* DT = (const float*)(WSP + WS_DT);
    bf16_t* AB = (bf16_t*)(WSP + WS_R + R_AB); float* ssq = (float*)(WSP + WS_SSQS);
    LAS float* acs = (LAS float*)(lds + SD_ACS); LAS float* dts = (LAS float*)(lds + SD_DT); LAS float* fs = (LAS float*)(lds + SD_F);
    for (int u2 = blockIdx.x; u2 < NB * 32; u2 += gridDim.x) {
        const int u = u2 >> 1, half = u2 & 1;
        const int b = u >> 4, h = u & 15, g = h >> 3;
        const float ah = -__expf(INP(12)[e * 16 + h]), Dh = INP(13)[e * 16 + h];
        const size_t rowbase = (size_t)b * T_;
        f32x16 st;
#pragma unroll
        for (int i = 0; i < 16; ++i) st[i] = 0.f;
        __syncthreads();
        for (int i = tid; i < 64 * SD_BP / 4; i += NTHR) ((LAS unsigned*)(lds + SD_S))[i] = 0u;
        for (int ck = 0; ck < (half ? 33 : 17); ++ck) {
            const bool light = half && ck < 17;
            const int t0 = ck * 128, nv = (T_ - t0) < 128 ? (T_ - t0) : 128;
            u32x4 gb[4], gc[4], gx[2];
#pragma unroll
            for (int k = 0; k < 4; ++k) { const int c = tid + 512 * k, row = c >> 4, cc = c & 15; gb[k] = (u32x4){0u, 0u, 0u, 0u}; gc[k] = gb[k];
                if (row < nv) { const bf16_t* src = XC + (rowbase + t0 + row) * 1536 + 1024 + g * 128 + cc * 8; gb[k] = *(const u32x4*)src; gc[k] = *(const u32x4*)(src + 256); } }
#pragma unroll
            for (int k = 0; k < 2; ++k) { const int c = tid + 512 * k, row = c >> 3, cc = c & 7; gx[k] = (u32x4){0u, 0u, 0u, 0u};
                if (row < nv) gx[k] = *(const u32x4*)(XC + (rowbase + t0 + row) * 1536 + h * 64 + cc * 8); }
            float dtv = 0.f; if (tid < nv) dtv = DT[(rowbase + t0 + tid) * 16 + h];
            __syncthreads();
#pragma unroll
            for (int k = 0; k < 4; ++k) { const int c = tid + 512 * k, row = c >> 4, cc = c & 15;
                *(LAS u32x4*)(lds + SD_B + row * SD_BP + cc * 16) = gb[k]; *(LAS u32x4*)(lds + SD_C + row * SD_BP + cc * 16) = gc[k]; }
#pragma unroll
            for (int k = 0; k < 2; ++k) { const int c = tid + 512 * k, row = c >> 3, cc = c & 7; *(LAS u32x4*)(lds + SD_X + row * SD_XP + cc * 16) = gx[k]; }
            if (tid < 128) dts[tid] = dtv;
            __syncthreads();
            if (wid == 0) {
                const float v0 = dts[2 * lane] * ah, v1 = dts[2 * lane + 1] * ah; float sc = v0 + v1;
#pragma unroll
                for (int o = 1; o < 64; o <<= 1) { const float t = __shfl_up(sc, o); if (lane >= o) sc += t; }
                acs[2 * lane + 1] = sc; acs[2 * lane] = sc - v1;
            }
            __syncthreads();
            const float aend = acs[127];
            if (tid < 128) fs[tid] = dts[tid] * __expf(aend - acs[tid]);
            __syncthreads();
#pragma unroll
            for (int k = 0; k < 2; ++k) { const int c = tid + 512 * k, row = c >> 3, cc = c & 7; const float f = fs[row]; const u32x4 xv = gx[k]; u32x4 o;
                o.x = pk2(bflo(xv.x) * f, bfhi(xv.x) * f); o.y = pk2(bflo(xv.y) * f, bfhi(xv.y) * f); o.z = pk2(bflo(xv.z) * f, bfhi(xv.z) * f); o.w = pk2(bflo(xv.w) * f, bfhi(xv.w) * f);
                *(LAS u32x4*)(lds + SD_XS + row * SD_XP + cc * 16) = o; }
            __syncthreads();
            f32x16 y;
            if (!light) {
            bf16x8 cf[8];
#pragma unroll
            for (int ks = 0; ks < 8; ++ks) cf[ks] = *(const LAS bf16x8*)(lds + SD_C + (32 * lb + r) * SD_BP + (16 * ks + 8 * hh) * 2);
#pragma unroll
            for (int i = 0; i < 16; ++i) y[i] = 0.f;
#pragma unroll
            for (int ks = 0; ks < 8; ++ks) { const bf16x8 sf = *(const LAS bf16x8*)(lds + SD_S + (32 * pb + r) * SD_BP + (16 * ks + 8 * hh) * 2); y = MFMA32(sf, cf[ks], y); }
            const float al = acs[32 * lb + r], eal = __expf(al);
#pragma unroll
            for (int i = 0; i < 16; ++i) y[i] *= eal;
            for (int sb = 0; sb <= lb; ++sb) {
                f32x16 cb;
#pragma unroll
                for (int i = 0; i < 16; ++i) cb[i] = 0.f;
#pragma unroll
                for (int ks = 0; ks < 8; ++ks) { const bf16x8 bfr = *(const LAS bf16x8*)(lds + SD_B + (32 * sb + r) * SD_BP + (16 * ks + 8 * hh) * 2); cb = MFMA32(bfr, cf[ks], cb); }
#pragma unroll
                for (int i = 0; i < 16; ++i) { const int sl = (i & 3) + 8 * (i >> 2) + 4 * hh, s = 32 * sb + sl;
                    const float w = __expf(al - acs[s]) * dts[s]; const bool keep = (sb < lb) || (sl <= r); cb[i] = keep ? cb[i] * w : 0.f; }
#pragma unroll
                for (int s2 = 0; s2 < 2; ++s2) {
                    u32x4 pw; pw.x = pk2(cb[8 * s2], cb[8 * s2 + 1]); pw.y = pk2(cb[8 * s2 + 2], cb[8 * s2 + 3]); pw.z = pk2(cb[8 * s2 + 4], cb[8 * s2 + 5]); pw.w = pk2(cb[8 * s2 + 6], cb[8 * s2 + 7]);
                    const LAS unsigned char* xa = lds + SD_X + (32 * sb + 16 * s2 + 4 * hh + q4) * SD_XP + pb * 64 + 32 * blk + 8 * p4;
                    const s16x4 lo = vtr(xa), hi = vtr(xa + 8 * SD_XP);
                    const bf16x8 xf = {lo[0], lo[1], lo[2], lo[3], hi[0], hi[1], hi[2], hi[3]};
                    y = MFMA32(xf, __builtin_bit_cast(bf16x8, pw), y);
                }
            }
            }
            { const float cd = __expf(aend);
#pragma unroll
              for (int i = 0; i < 16; ++i) st[i] *= cd;
#pragma unroll
              for (int ks = 0; ks < 8; ++ks) {
                  const LAS unsigned char* ba = lds + SD_B + (16 * ks + 8 * hh + q4) * SD_BP + lb * 64 + 32 * blk + 8 * p4;
                  const s16x4 blo = vtr(ba), bhi = vtr(ba + 4 * SD_BP);
                  const bf16x8 bt = {blo[0], blo[1], blo[2], blo[3], bhi[0], bhi[1], bhi[2], bhi[3]};
                  const LAS unsigned char* xa = lds + SD_XS + (16 * ks + 8 * hh + q4) * SD_XP + pb * 64 + 32 * blk + 8 * p4;
                  const s16x4 xlo = vtr(xa), xhi = vtr(xa + 4 * SD_XP);
                  const bf16x8 xs = {xlo[0], xlo[1], xlo[2], xlo[3], xhi[0], xhi[1], xhi[2], xhi[3]};
                  st = MFMA32(bt, xs, st);
              } }
            if (!light) { const int l = 32 * lb + r; float q = 0.f;
              if (l < nv) {
#pragma unroll
                  for (int gq = 0; gq < 4; ++gq) { const int p0 = 32 * pb + 8 * gq + 4 * hh;
                      const u32x2 xv = *(const LAS u32x2*)(lds + SD_X + l * SD_XP + p0 * 2);
                      u32x2* zp = (u32x2*)(AB + (rowbase + t0 + l) * 2048 + h * 64 + p0); const u32x2 zv = *zp;
                      const float o0 = (y[4 * gq] + Dh * bflo(xv.x)) * siluf_(bflo(zv.x)), o1 = (y[4 * gq + 1] + Dh * bfhi(xv.x)) * siluf_(bfhi(zv.x));
                      const float o2 = (y[4 * gq + 2] + Dh * bflo(xv.y)) * siluf_(bflo(zv.y)), o3 = (y[4 * gq + 3] + Dh * bfhi(xv.y)) * siluf_(bfhi(zv.y));
                      u32x2 w; w.x = pk2(o0, o1); w.y = pk2(o2, o3); if (!dry) *zp = w;
                      q += (o0 * o0 + o1 * o1) + (o2 * o2 + o3 * o3); }
              }
              q += __shfl_xor(q, 32);
              if (hh == 0 && l < nv && !dry) ssq[(rowbase + t0 + l) * 32 + h * 2 + pb] = q; }
            __syncthreads();
#pragma unroll
            for (int gq = 0; gq < 4; ++gq) { u32x2 w; w.x = pk2(st[4 * gq], st[4 * gq + 1]); w.y = pk2(st[4 * gq + 2], st[4 * gq + 3]);
                *(LAS u32x2*)(lds + SD_S + (32 * pb + r) * SD_BP + (32 * lb + 8 * gq + 4 * hh) * 2) = w; }
        }
    }
}

constexpr int AT_KP = 208, AT_VP = 192, AT_KB = 64 * AT_KP, AT_VB = 64 * AT_VP;
constexpr int AT_NQB = 17, AT_NU = NB * 16 * AT_NQB;
__device__ __forceinline__ void attn_phase(PTAB ptab, int wv_, LAS unsigned char* lds, unsigned* counter) {
    const int tid = tid_opaque(), lane = tid & 63, wid = __builtin_amdgcn_readfirstlane(tid >> 6), r = lane & 31, hh = lane >> 5;
    const bf16_t* Q = (const bf16_t*)(OUTB + DO_Q); const bf16_t* KV = (const bf16_t*)(WSP + WS_R + R_KV); const bf16_t* KR = (const bf16_t*)(WSP + WS_KR);
    bf16_t* AB = (bf16_t*)(WSP + WS_R + R_AB);
    LAS unsigned* slot = (LAS unsigned*)(lds + 2 * AT_KB + 2 * AT_VB);
    const unsigned xcc0 = xcc_id_() & 7u;
    if (wid < 4) __builtin_amdgcn_s_setprio(2);
    const int c0r = tid >> 4, c0c = tid & 15, c1r = c0r + 32, rkr = (tid & 255) >> 2, rkc = tid & 3;
    const int d0off = c0c < 8 ? c0r * AT_KP + c0c * 16 : 2 * AT_KB + c0r * AT_VP + (c0c - 8) * 16;
    const int d1off = c0c < 8 ? c1r * AT_KP + c0c * 16 : 2 * AT_KB + c1r * AT_VP + (c0c - 8) * 16;
    const int dboff = c0c < 8 ? AT_KB : AT_VB, drope = rkr * AT_KP + 128 + rkc * 16;
    const int q4 = (lane & 15) >> 2, p4 = lane & 3, blk = (lane >> 4) & 1;
    for (int xo = 0; xo < 1; ++xo) {
    const unsigned xcc = 0u; (void)xcc0;
    for (;;) {
        __syncthreads();
        if (tid == 0) *slot = atomicAdd(counter + 16 * xcc, 1u);
        __syncthreads();
        const unsigned ui = *slot;
        if (ui >= (unsigned)AT_NU) break;
        const int qb = 16 - (int)(ui >> 7), bh = (int)(ui & 127u), b = bh >> 4, h = bh & 15;
        const int q0 = qb == 0 ? 0 : 16 + 256 * (qb - 1); const size_t rowbase = (size_t)b * T_;
        const int qend = qb == 0 ? 16 : q0 + 256, nt = (qend + 63) >> 6;
        const int qrow = q0 + 32 * wid + r, qrc = qrow < T_ ? qrow : (T_ - 1);
        const int qwmin = q0 + 32 * wid, qwmax = qwmin + 31;
        bf16x8 qf[6];
        { const bf16_t* qp = Q + (rowbase + qrc) * 1536 + h * 96 + 8 * hh;
#pragma unroll
          for (int ks = 0; ks < 6; ++ks) qf[ks] = *(const GAS bf16x8*)(qp + 16 * ks); }
        float m_run = 0.f, l_run = 0.f; f32x16 o[2];
#pragma unroll
        for (int i = 0; i < 16; ++i) { o[0][i] = 0.f; o[1][i] = 0.f; }
        u32x4 gk0[2], gk1[2], gv[2];
#define AT_BAR() asm volatile("s_waitcnt lgkmcnt(0)\n\ts_barrier" ::: "memory")
#define AT_LOAD(t, S) do { const int kb_ = (t) * 64; \
        { int rr = kb_ + c0r; rr = rr < T_ ? rr : T_ - 1; gk0[S] = *(const GAS u32x4*)(KV + (rowbase + rr) * 2048 + h * 128 + c0c * 8); } \
        { int rr = kb_ + c1r; rr = rr < T_ ? rr : T_ - 1; gk1[S] = *(const GAS u32x4*)(KV + (rowbase + rr) * 2048 + h * 128 + c0c * 8); } \
        { int rr = kb_ + rkr; rr = rr < T_ ? rr : T_ - 1; gv[S] = *(const GAS u32x4*)(KR + (rowbase + rr) * 32 + rkc * 8); } } while (0)
#define AT_STORE(buf, S) do { *(LAS u32x4*)(lds + d0off + (buf) * dboff) = gk0[S]; *(LAS u32x4*)(lds + d1off + (buf) * dboff) = gk1[S]; \
        *(LAS u32x4*)(lds + (buf) * AT_KB + drope) = gv[S]; } while (0)
        AT_LOAD(0, 0); AT_STORE(0, 0);
        if (nt > 1) AT_LOAD(1, 1);
        if (nt > 2) AT_LOAD(2, 0);
        AT_BAR();
        for (int t2 = 0; t2 < nt; t2 += 2) {
#pragma unroll
          for (int hf = 0; hf < 2; ++hf) {
            const int t = t2 + hf, cur = hf;
            if (t < nt) {
            if (t * 64 <= qwmax && qwmin < qend) {
                const LAS unsigned char* kb = lds + cur * AT_KB; const LAS unsigned char* vb = lds + 2 * AT_KB + cur * AT_VB;
                f32x16 p0, p1;
#pragma unroll
                for (int i = 0; i < 16; ++i) { p0[i] = -m_run; p1[i] = -m_run; }
                bf16x8 kf[12], vf[8];
#pragma unroll
                for (int ks = 0; ks < 6; ++ks) { kf[2 * ks] = *(const LAS bf16x8*)(kb + r * AT_KP + (16 * ks + 8 * hh) * 2); kf[2 * ks + 1] = *(const LAS bf16x8*)(kb + (32 + r) * AT_KP + (16 * ks + 8 * hh) * 2); }
#pragma unroll
                for (int i8 = 0; i8 < 8; ++i8) { const int kbk = i8 >> 2, s = (i8 >> 1) & 1, dv = i8 & 1;
                    const LAS unsigned char* va = vb + (32 * kbk + 16 * s + 4 * hh + q4) * AT_VP + dv * 64 + 32 * blk + 8 * p4;
                    const s16x4 lo = vtr(va), hi = vtr(va + 8 * AT_VP);
                    vf[i8] = (bf16x8){lo[0], lo[1], lo[2], lo[3], hi[0], hi[1], hi[2], hi[3]}; }
                __builtin_amdgcn_sched_barrier(0);
#pragma unroll
                for (int ks = 0; ks < 6; ++ks) { p0 = MFMA32(kf[2 * ks], qf[ks], p0); p1 = MFMA32(kf[2 * ks + 1], qf[ks], p1); }
                __builtin_amdgcn_sched_barrier(0);
                if (t * 64 + 63 > qwmin) {
#pragma unroll
                    for (int i = 0; i < 16; ++i) { const int kv = t * 64 + (i & 3) + 8 * (i >> 2) + 4 * hh;
                        if (kv > qrow) p0[i] = -INFINITY; if (kv + 32 > qrow) p1[i] = -INFINITY; }
                }
                float mxa = fmaxf(p0[0], p1[0]), mxb = fmaxf(p0[1], p1[1]);
#pragma unroll
                for (int i = 2; i < 16; i += 2) { mxa = fmaxf(fmaxf(mxa, p0[i]), p1[i]); mxb = fmaxf(fmaxf(mxb, p0[i + 1]), p1[i + 1]); }
                float mx = fmaxf(mxa, mxb);
                { const auto sw_ = __builtin_amdgcn_permlane32_swap(__float_as_uint(mx), __float_as_uint(mx), false, false); mx = fmaxf(__uint_as_float(sw_[0]), __uint_as_float(sw_[1])); }
                if (t == 0 || __builtin_amdgcn_ballot_w64(mx > 8.0f) != 0ull) {
                    const float d = (t == 0) ? mx : fmaxf(mx, 0.f), alpha = __builtin_amdgcn_exp2f(-d);
                    m_run += d; l_run *= alpha;
#pragma unroll
                    for (int i = 0; i < 16; ++i) { p0[i] -= d; p1[i] -= d; o[0][i] *= alpha; o[1][i] *= alpha; }
                }
                float rsa = 0.f, rsb = 0.f;
#pragma unroll
                for (int i = 0; i < 16; ++i) { p0[i] = __builtin_amdgcn_exp2f(p0[i]); p1[i] = __builtin_amdgcn_exp2f(p1[i]);
                    asm("v_add_f32_e32 %0, %1, %2" : "=v"(rsa) : "v"(rsa), "v"(p0[i])); asm("v_add_f32_e32 %0, %1, %2" : "=v"(rsb) : "v"(rsb), "v"(p1[i])); }
                const float rs = rsa + rsb;
                l_run += rs;
#pragma unroll
                for (int kbk = 0; kbk < 2; ++kbk)
#pragma unroll
                    for (int s = 0; s < 2; ++s) {
                        u32x4 pw;
                        if (kbk == 0) { pw.x = pk2(p0[8 * s], p0[8 * s + 1]); pw.y = pk2(p0[8 * s + 2], p0[8 * s + 3]); pw.z = pk2(p0[8 * s + 4], p0[8 * s + 5]); pw.w = pk2(p0[8 * s + 6], p0[8 * s + 7]); }
                        else { pw.x = pk2(p1[8 * s], p1[8 * s + 1]); pw.y = pk2(p1[8 * s + 2], p1[8 * s + 3]); pw.z = pk2(p1[8 * s + 4], p1[8 * s + 5]); pw.w = pk2(p1[8 * s + 6], p1[8 * s + 7]); }
                        const bf16x8 pf = __builtin_bit_cast(bf16x8, pw);
#pragma unroll
                        for (int dv = 0; dv < 2; ++dv) o[dv] = MFMA32(vf[kbk * 4 + s * 2 + dv], pf, o[dv]);
                    }
            }
            if (t + 1 < nt) AT_STORE(cur ^ 1, hf ^ 1);
            if (t + 3 < nt) AT_LOAD(t + 3, hf ^ 1);
            AT_BAR();
            }
          }
        }
        if (qrow < qend) {
            const float il = 1.0f / (l_run + __shfl_xor(l_run, 32));
            bf16_t* op = AB + (rowbase + qrow) * 2048 + 1024 + h * 64;
#pragma unroll
            for (int dv = 0; dv < 2; ++dv)
#pragma unroll
                for (int gq = 0; gq < 4; ++gq) { u32x2 w; w.x = pk2(o[dv][4 * gq] * il, o[dv][4 * gq + 1] * il); w.y = pk2(o[dv][4 * gq + 2] * il, o[dv][4 * gq + 3] * il);
                    *(u32x2*)(op + dv * 32 + 8 * gq + 4 * hh) = w; }
        }
    }
    }
    __builtin_amdgcn_s_setprio(0);
#undef AT_LOAD
#undef AT_BAR
#undef AT_STORE
}

#define XB_TMO      128
#define XB_XCNT(j)  (256  + 64 * (j))
#define XB_XSUB(j)  (1280 + 64 * (j))
#define XB_XGEN(j)  (2304 + 64 * (j))
#define XB_TOP      3328
#define XB_TOPGEN   3392
#define XCD_BAR_WORDS 3456
#define XB_SPIN_CAP (1u << 18)

__device__ __forceinline__ unsigned xb_ld(unsigned* p)              { return __hip_atomic_load(p, __ATOMIC_RELAXED, __HIP_MEMORY_SCOPE_AGENT); }
__device__ __forceinline__ unsigned xb_add(unsigned* p, unsigned v) { return __hip_atomic_fetch_add(p, v, __ATOMIC_RELAXED, __HIP_MEMORY_SCOPE_AGENT); }
__device__ __forceinline__ unsigned xb_xcc_id() { return (unsigned)__builtin_amdgcn_s_getreg((3 << 11) | 20) & 0xFu; }
#define XB_SPIN(cond, bar) do { unsigned _sp = 0; while (cond) { __builtin_amdgcn_s_sleep(1); \
    if ((++_sp & 255u) == 0u) { if (xb_ld(&(bar)[XB_TMO])) break; if (_sp > XB_SPIN_CAP) { atomicAdd(&(bar)[XB_TMO], 1u); break; } } } } while (0)

struct XcdBarrier {
    unsigned* bar; unsigned x;
    volatile LAS unsigned* st;
};

__device__ __forceinline__ XcdBarrier xcd_barrier_post(unsigned* bar, volatile LAS unsigned* st, int wv_) {
    XcdBarrier b; b.bar = bar; b.x = xb_xcc_id(); b.st = st;
    if (tid_opaque() == 0) (void)xb_add(&bar[XB_XCNT(b.x)], 1u);
    return b;
}
__device__ __forceinline__ void xcd_barrier_complete(unsigned* bar, unsigned x, unsigned& nloc, unsigned& nx) {
    const unsigned G = gridDim.x * gridDim.y * gridDim.z;
    unsigned sum, cnt, mine, sp = 0u;
    for (;;) {
        sum = 0u; cnt = 0u; mine = 0u;
#pragma unroll
        for (unsigned j = 0; j < 16; ++j) { const unsigned c = xb_ld(&bar[XB_XCNT(j)]); sum += c; cnt += (c > 0u) ? 1u : 0u; mine = (j == x) ? c : mine; }
        if (sum == G) break;
        __builtin_amdgcn_s_sleep(1);
        if ((++sp & 255u) == 0u) { if (xb_ld(&bar[XB_TMO])) break; if (sp > XB_SPIN_CAP) { atomicAdd(&bar[XB_TMO], 1u); break; } }
    }
    nloc = mine > 0u ? mine : 1u; nx = cnt > 0u ? cnt : 1u;
}

__device__ __forceinline__ void xcd_barrier(const XcdBarrier& b, int wv_) {
    asm volatile("s_waitcnt vmcnt(0)" ::: "memory");
    __syncthreads();
    if (tid_opaque() == 0) {
        unsigned* bar = b.bar;
        __builtin_amdgcn_s_waitcnt(0);
        unsigned nloc = b.st[0], nx = b.st[1];
        if (nloc == 0u) { xcd_barrier_complete(bar, b.x, nloc, nx); b.st[0] = nloc; b.st[1] = nx; }
        const unsigned old = xb_add(&bar[XB_XSUB(b.x)], 1u);
        const unsigned gen = old / nloc;
        if (old + 1u == (gen + 1u) * nloc) {
            __builtin_amdgcn_fence(__ATOMIC_RELEASE, "agent");
            asm volatile("s_waitcnt vmcnt(0)" ::: "memory");
            const unsigned og = xb_add(&bar[XB_TOP], 1u);
            const unsigned tg = og / nx;
            if (og + 1u == (tg + 1u) * nx) xb_add(&bar[XB_TOPGEN], 1u);
            else XB_SPIN(xb_ld(&bar[XB_TOPGEN]) == tg, bar);
            __builtin_amdgcn_fence(__ATOMIC_ACQUIRE, "agent");
            xb_add(&bar[XB_XGEN(b.x)], 1u);
            asm volatile("s_waitcnt vmcnt(0)" ::: "memory");
        } else {
            XB_SPIN(xb_ld(&bar[XB_XGEN(b.x)]) == gen, bar);
            __builtin_amdgcn_fence(__ATOMIC_ACQUIRE, "agent");
            asm volatile("s_waitcnt vmcnt(0)" ::: "memory");
        }
    }
    __syncthreads();
}

__global__ void __launch_bounds__(NTHR) hybrid_fwd(Params P) {
    extern __shared__ __attribute__((aligned(16))) unsigned char lds_raw[];
    LAS unsigned char* lds = (LAS unsigned char*)lds_raw;
    cg::grid_group grid = cg::this_grid();
    const int wv_ = __builtin_amdgcn_readfirstlane(threadIdx.x >> 6);
    PTAB ptab = (PTAB)__builtin_amdgcn_kernarg_segment_ptr();
#if PROBE & 1
#define GBAR() do { GBAR1(); GBAR1(); } while (0)
#else
#define GBAR() GBAR1()
#endif
#define GBAR1() do { unsigned sta_ = (unsigned)LDS_CTL + 64u; asm volatile("" : "+v"(sta_)); XcdBarrier xb_; xb_.bar = (unsigned*)(WSP + WS_CTL) + 1024; xb_.x = xb_xcc_id(); \
    xb_.st = (volatile LAS unsigned*)(lds + sta_); xcd_barrier(xb_, wv_); } while (0)
#define ws WSP
#define dob OUTB
#define rstd_h ((float*)(WSP + WS_RSTDH))
#define ssqm ((float*)(WSP + WS_SSQM))
#define HB ((bf16_t*)(WSP + WS_HB))
#define WOFF(o) ((bf16_t*)(WSP + WS_W + (o)))
    { volatile LAS unsigned* st0 = (volatile LAS unsigned*)(lds + LDS_CTL + 64); if (tid_opaque() == 0) { st0[0] = 0u; st0[1] = 0u; } __syncthreads(); }
    (void)xcd_barrier_post((unsigned*)(WSP + WS_CTL) + 1024, (volatile LAS unsigned*)(lds + LDS_CTL + 64), wv_);
    unsigned my_rank_ = 0, my_xcc_ = xb_xcc_id();
    if (tid_opaque() == 0) my_rank_ = __hip_atomic_fetch_add((unsigned*)(WSP + WS_CTL) + 512 + 16 * my_xcc_, 1u, __ATOMIC_RELAXED, __HIP_MEMORY_SCOPE_AGENT);
    grid.sync();
    { volatile LAS unsigned* vc = (volatile LAS unsigned*)(lds + LDS_CTL + 128);
      if (tid_opaque() == 0) { bool ok = (gridDim.x & 7u) == 0u;
          for (int j = 0; j < 8; ++j) ok = ok && (__hip_atomic_load((unsigned*)(WSP + WS_CTL) + 512 + 16 * j, __ATOMIC_RELAXED, __HIP_MEMORY_SCOPE_AGENT) == gridDim.x / 8u);
          vc[0] = ok ? (my_rank_ * 8u + my_xcc_) : blockIdx.x; }
      __syncthreads(); }
#if PROBE & 128
    convert_layer(ptab, wv_, 0, lds);
    setup_rows(ptab, wv_);
#endif
    convert_layer(ptab, wv_, 0, lds);
    setup_rows(ptab, wv_);
    GBAR();
#pragma unroll 1
    for (int L = 0; L < 4; ++L) {
        if ((L & 1) == 0) {
            const int e = L >> 1;
            bf16_t* AB = (bf16_t*)(ws + WS_R + R_AB); bf16_t* LAT = (bf16_t*)(ws + WS_R + R_LAT); bf16_t* XKV = (bf16_t*)(ws + WS_R + R_KV); bf16_t* Qb = (bf16_t*)(dob + DO_Q);
#if PROBE & 256
            { Epi<EP_IN> E{rstd_h, AB, XKV, LAT, nullptr, nullptr, nullptr, nullptr, nullptr};
              run_gemm<EP_IN>(wv_, lds, HB, 1024, 0, WOFF(W_IN), 3328, 1024, E); }
            GBAR();
#endif
            { Epi<EP_IN> E{rstd_h, AB, XKV, LAT, nullptr, nullptr, nullptr, nullptr, nullptr};
              run_gemm<EP_IN>(wv_, lds, HB, 1024, 0, WOFF(W_IN), 3328, 1024, E); }
            GBAR();
#if PROBE & 64
            prep_phase(ptab, wv_, e); GBAR();
#endif
            prep_phase(ptab, wv_, e);
            GBAR();
#if PROBE & 2
            ssd_phase(ptab, wv_, e, lds, true); GBAR();
#endif
            ssd_phase(ptab, wv_, e, lds);
            GBAR();
#if PROBE & 512
            { Epi<EP_Q> E{(const float*)(ws + WS_RSTDQ), Qb, nullptr, nullptr, nullptr, (const float*)(ws + WS_COS), (const float*)(ws + WS_SIN), nullptr, nullptr};
              run_gemm<EP_Q>(wv_, lds, LAT, 768, 0, WOFF(W_Q), 1536, 384, E); }
            { Epi<EP_KV> E{(const float*)(ws + WS_RSTDKV), XKV, nullptr, nullptr, nullptr, nullptr, nullptr, nullptr, nullptr};
              run_gemm<EP_KV>(wv_, lds, LAT + 384, 768, 0, WOFF(W_KV), 2048, 256, E); }
            GBAR();
#endif
            { Epi<EP_Q> E{(const float*)(ws + WS_RSTDQ), Qb, nullptr, nullptr, nullptr, (const float*)(ws + WS_COS), (const float*)(ws + WS_SIN), nullptr, nullptr};
              run_gemm<EP_Q>(wv_, lds, LAT, 768, 0, WOFF(W_Q), 1536, 384, E); }
            { Epi<EP_KV> E{(const float*)(ws + WS_RSTDKV), XKV, nullptr, nullptr, nullptr, nullptr, nullptr, nullptr, nullptr};
              run_gemm<EP_KV>(wv_, lds, LAT + 384, 768, 0, WOFF(W_KV), 2048, 256, E); }
#if PROBE & 64
            fix_phase(ptab, wv_, true);
#endif
            fix_phase(ptab, wv_);
            GBAR();
#if PROBE & 4
            attn_phase(ptab, wv_, lds, (unsigned*)(ws + WS_CTL) + 6144 + 256 * e); GBAR();
#endif
            attn_phase(ptab, wv_, lds, (unsigned*)(ws + WS_CTL) + 5120 + 256 * e);
            GBAR();
#if PROBE & 4096
            { Epi<EP_M> E{nullptr, (bf16_t*)(ws + WS_M), nullptr, nullptr, ssqm, nullptr, nullptr, nullptr, nullptr};
              run_gemm<EP_M, 1>(wv_, lds, AB, 2048, 0, WOFF(W_O), 1024, 2048, E); }
            GBAR();
#endif
            { Epi<EP_M> E{nullptr, (bf16_t*)(ws + WS_M), nullptr, nullptr, ssqm, nullptr, nullptr, nullptr, nullptr};
              run_gemm<EP_M, 1>(wv_, lds, AB, 2048, 0, WOFF(W_O), 1024, 2048, E); }
        } else {
            const int o = L >> 1;
            bf16_t* X = (bf16_t*)(ws + WS_R + R_X); bf16_t* G = (bf16_t*)(ws + WS_R + R_G); bf16_t* XR = (bf16_t*)(ws + WS_R + R_XR); bf16_t* U = (bf16_t*)(dob + DO_Q);
#if PROBE & 1024
            { Epi<EP_XY> E{rstd_h, X, G, nullptr, nullptr, nullptr, nullptr, nullptr, nullptr};
              run_gemm<EP_XY>(wv_, lds, HB, 1024, 0, WOFF(W_XY), 2560, 1024, E); }
            GBAR();
#endif
            { Epi<EP_XY> E{rstd_h, X, G, nullptr, nullptr, nullptr, nullptr, nullptr, nullptr};
              run_gemm<EP_XY>(wv_, lds, HB, 1024, 0, WOFF(W_XY), 2560, 1024, E); }
            GBAR();
#if PROBE & 64
            rgconv_phase(ptab, wv_, o); GBAR();
#endif
            rgconv_phase(ptab, wv_, o);
            GBAR();
            { Epi<EP_AI> E{nullptr, X, U, nullptr, nullptr, INP(25) + o * 1280, INP(27) + o * 1280, INP(28) + o * 1280, XR};
              run_gemm<EP_AI>(wv_, lds, XR, 1280, 128, WOFF(W_AI), 2560, 128, E); }
            GBAR();
#if PROBE & 32
            scan_a_phase(ptab, wv_); GBAR(); scan_c_phase(ptab, wv_, true); GBAR();
#endif
            scan_a_phase(ptab, wv_);
            GBAR();
            scan_c_phase(ptab, wv_);
            GBAR();
            { Epi<EP_M> E{nullptr, (bf16_t*)(ws + WS_M), nullptr, nullptr, ssqm, nullptr, nullptr, nullptr, nullptr};
              run_gemm<EP_M, 1>(wv_, lds, U, 1280, 0, WOFF(W_RO), 1024, 1280, E); }
        }
        GBAR();
        { Epi<EP_PART> E{nullptr, nullptr, nullptr, nullptr, nullptr, (const float*)(ws + WS_PART), nullptr, nullptr, nullptr};
          if ((L & 1) == 0) run_gemm_tail<EP_PART>(wv_, lds, (bf16_t*)(ws + WS_R + R_AB), 2048, WOFF(W_O), 2048, 1024, 2, E);
          else run_gemm_tail<EP_PART>(wv_, lds, (bf16_t*)(dob + DO_Q), 1280, WOFF(W_RO), 1280, 640, 2, E); }
#if PROBE & 16
        resnorm_phase(ptab, wv_, lds, INP(3) + L * 1024, false, 0, MP - 256, 8, true);
#endif
        resnorm_phase(ptab, wv_, lds, INP(3) + L * 1024, false, 0, MP - 256, 8);
        GBAR();
        tail_reduce_resnorm(ptab, wv_, INP(3) + L * 1024, false, 2);
        GBAR();
#if PROBE & 8
        { Epi<EP_UP> E{rstd_h, (bf16_t*)(ws + WS_R + R_U), nullptr, nullptr, nullptr, nullptr, nullptr, nullptr, nullptr};
          run_gemm<EP_UP>(wv_, lds, HB, 1024, 0, WOFF(W_UP), 4096, 1024, E); }
        GBAR();
#endif
        { Epi<EP_UP> E{rstd_h, (bf16_t*)(ws + WS_R + R_U), nullptr, nullptr, nullptr, nullptr, nullptr, nullptr, nullptr};
          run_gemm<EP_UP>(wv_, lds, HB, 1024, 0, WOFF(W_UP), 4096, 1024, E); }
        GBAR();
#if PROBE & 2048
        { Epi<EP_M> E{nullptr, (bf16_t*)(ws + WS_M), nullptr, nullptr, ssqm, nullptr, nullptr, nullptr, nullptr};
          run_gemm<EP_M, 1>(wv_, lds, (bf16_t*)(ws + WS_R + R_U), 4096, 0, WOFF(W_DN), 1024, 4096, E); }
            GBAR();
#endif
        { Epi<EP_M> E{nullptr, (bf16_t*)(ws + WS_M), nullptr, nullptr, ssqm, nullptr, nullptr, nullptr, nullptr};
          run_gemm<EP_M, 1>(wv_, lds, (bf16_t*)(ws + WS_R + R_U), 4096, 0, WOFF(W_DN), 1024, 4096, E); }
        GBAR();
        { Epi<EP_PART> E{nullptr, nullptr, nullptr, nullptr, nullptr, (const float*)(ws + WS_PART), nullptr, nullptr, nullptr};
          run_gemm_tail<EP_PART>(wv_, lds, (bf16_t*)(ws + WS_R + R_U), 4096, WOFF(W_DN), 4096, 1024, 4, E); }
#if PROBE & 16
        resnorm_phase(ptab, wv_, lds, INP(5) + L * 1024, false, 0, MP - 256, 16, true);
#endif
        resnorm_phase(ptab, wv_, lds, INP(5) + L * 1024, L == 3, 0, MP - 256, 16);
        GBAR();
#if PROBE & 128
        if (L < 3) convert_layer(ptab, wv_, L + 1, lds);
#endif
        if (L < 3) { convert_layer(ptab, wv_, L + 1, lds); tail_reduce_resnorm(ptab, wv_, INP(5) + L * 1024, false, 4); GBAR(); }
        else tail_reduce_resnorm(ptab, wv_, INP(5) + L * 1024, true, 4);
    }
#undef WOFF
#undef ws
#undef dob
#undef rstd_h
#undef ssqm
#undef HB
}

extern "C" void kernel_launch(void* const* d_in, const int* in_sizes, int n_in, void* d_out, int out_size, void* d_ws, size_t ws_size, hipStream_t stream) {
    static int grid_blocks = 0;
    if (grid_blocks == 0) {
        if (n_in != 30 || ws_size < WS_NEED || (size_t)out_size * 4 < DO_Q + (size_t)MP * 1536 * 2) { fprintf(stderr, "kernel_launch: unexpected shapes (n_in %d, ws %zu need %zu, out %d)\n", n_in, ws_size, (size_t)WS_NEED, out_size); grid_blocks = -1; return; }
        int dev = 0, cus = 0, per_cu = 0;
        hipGetDevice(&dev); hipDeviceGetAttribute(&cus, hipDeviceAttributeMultiprocessorCount, dev);
        if (hipFuncSetAttribute((const void*)hybrid_fwd, hipFuncAttributeMaxDynamicSharedMemorySize, LDS_BYTES) != hipSuccess) { fprintf(stderr, "kernel_launch: hipFuncSetAttribute failed\n"); grid_blocks = -1; return; }
        if (hipOccupancyMaxActiveBlocksPerMultiprocessor(&per_cu, (const void*)hybrid_fwd, NTHR, LDS_BYTES) != hipSuccess || per_cu < 1) { fprintf(stderr, "kernel_launch: occupancy query says %d\n", per_cu); per_cu = 1; }
        (void)hipGetLastError();
        grid_blocks = cus * 1;
    }
    if (grid_blocks < 0) return;
    hipMemsetAsync((char*)d_ws + WS_CTL, 0, CTL_BYTES, stream);
    Params p{};
    for (int i = 0; i < 30; ++i) p.in[i] = (const float*)d_in[i];
    p.out = (float*)d_out; p.ws = (unsigned char*)d_ws;
    void* args[] = {&p};
    hipError_t e = hipLaunchCooperativeKernel((const void*)hybrid_fwd, dim3(grid_blocks), dim3(NTHR), args, LDS_BYTES, stream);
    if (e != hipSuccess) fprintf(stderr, "cooperative launch failed: %s (grid %d)\n", hipGetErrorString(e), grid_blocks);
}
```

```cpp
#include <hip/hip_runtime.h>
#include <hip/hip_cooperative_groups.h>
#include <cstdio>
#include <cstdint>
#include <cmath>
namespace cg = cooperative_groups;
#ifndef PROBE
#define PROBE 0
#endif
__device__ __forceinline__ int tid_from(int wv) { int t; asm volatile("v_mbcnt_lo_u32_b32 %0, -1, 0\n\tv_mbcnt_hi_u32_b32 %0, -1, %0\n\tv_lshl_add_u32 %0, %1, 6, %0" : "=&v"(t) : "s"(wv)); return t; }
#define tid_opaque() tid_from(wv_)
namespace pg8 {
#define PG8_LAS __attribute__((address_space(3)))
typedef unsigned short bf16_t;
typedef short bf16x8 __attribute__((ext_vector_type(8)));
typedef float f32x4 __attribute__((ext_vector_type(4)));
typedef unsigned u32x4 __attribute__((ext_vector_type(4)));
constexpr int BM = 256, BK = 64, HALF = 128, HTB = HALF * BK * 2  , STAGE_BYTES = 8 * HTB, NXCD = 8, WGM = 8;

__host__ __device__ __forceinline__ int lds_byte(int r, int c) { const int st = (r >> 4) * 2 + (c >> 5), rr = r & 15, cc = c & 31, ob = rr * 64 + cc * 2; return st * 1024 + (ob ^ (((ob >> 9) & 1) << 5)); }
__host__ __device__ __forceinline__ void stage_rc(int b, int& R, int& C) { const int st = b / 1024, sb = b % 1024, swz = sb ^ (((sb >> 9) & 1) << 5); R = (st >> 1) * 16 + swz / 64; C = (st & 1) * 32 + (swz % 64) / 2; }
__host__ __device__ __forceinline__ int perm32(int rho) { const int n = rho >> 4, i = rho & 15; return 8 * (i >> 2) + 4 * n + (i & 3); }

struct Unit { int pm, pn; };
struct Gemm { const bf16_t* A; const bf16_t* Bt; int M, N, K, lda, ldb, a_pn, half_pm, nsplit_n, kofs; };

struct StaticOrder {
    int nM, nN, nwg, G, c;
    __host__ __device__ void init(int M, int N, int G_, int c_) { nM = M / BM; nN = N / BM; nwg = nM * nN; G = G_; c = c_; }
    __host__ __device__ bool next(int i, Unit& u) const {
        const long L = (long)i * G + c; if (L >= nwg) return false;
        int wgid = (int)L; { const int q = nwg / NXCD, r = nwg % NXCD, xcd = wgid % NXCD, off = wgid / NXCD; wgid = (xcd < r ? xcd * (q + 1) : r * (q + 1) + (xcd - r) * q) + off; }
        const int nig = WGM * nN, gid = wgid / nig, fm = gid * WGM, gsz = (nM - fm) < WGM ? (nM - fm) : WGM;
        u.pm = fm + ((wgid % nig) % gsz); u.pn = (wgid % nig) / gsz; return true;
    }
    __device__ __forceinline__ void a_ready(const Unit&) const {}
    __device__ __forceinline__ void done(const Unit&) const {}
};

__device__ __forceinline__ unsigned cvt_pk_bf16(float lo, float hi) { unsigned r; asm volatile("v_cvt_pk_bf16_f32 %0, %1, %2" : "=v"(r) : "v"(lo), "v"(hi)); return r; }
typedef float f32x2 __attribute__((ext_vector_type(2)));
template <class Epi, class Sched, bool ALIGN_EPI = false, bool SP2 = false>
__device__ __forceinline__ void gemm_phase(int wv_, PG8_LAS unsigned char* lds, const Gemm g, const Sched& S, const Epi& E) {
    const int tid = tid_opaque(), wid = __builtin_amdgcn_readfirstlane(tid >> 6), lane = tid & 63, wr = wid >> 2, wc = wid & 3, fr = lane & 15, fq = lane >> 4;
    const int K = g.K, nt = K / BK;
    unsigned voffA[2], voffB[2];
#pragma unroll
    for (int i = 0; i < 2; ++i) { int R, C; stage_rc(tid * 16 + i * 8192, R, C); const int Rb = Epi::PERM ? ((R & ~31) + perm32(R & 31)) : R;
        voffA[i] = (unsigned)(R * g.lda + C) * 2u; voffB[i] = (unsigned)(Rb * g.ldb + C) * 2u; }
    const size_t kstep = (size_t)(BK * 2);
    const size_t hstepA = (size_t)HALF * g.lda * 2, hstepB = (size_t)HALF * g.ldb * 2;
    const size_t tstepA = 2 * hstepA, tstepB = 2 * hstepB, pnA = (size_t)g.a_pn * 2;
    const unsigned ldsw = (unsigned)wid * 1024u;
    const int aoff = lds_byte(wr * 64 + fr, fq * 8), boff = lds_byte(wc * 32 + fr, fq * 8);
#define PG8_SA(b, h) (((b) * 2 + (h)) * HTB)
#define PG8_SB(b, h) ((4 + (b) * 2 + (h)) * HTB)
#define PG8_STAGE(bufoff, gbase, voff) do { _Pragma("unroll") for (int _i = 0; _i < 2; ++_i) \
        __builtin_amdgcn_global_load_lds((const unsigned*)((const char*)(gbase) + (voff)[_i]), (PG8_LAS unsigned*)(lds + (bufoff) + ldsw + _i * 8192), 16, 0, 0); } while (0)
#define PG8_LDA(dst, b, h) do { _Pragma("unroll") for (int m = 0; m < 4; ++m) _Pragma("unroll") for (int k = 0; k < 2; ++k) dst[m][k] = *(const PG8_LAS bf16x8*)(lds + PG8_SA(b, h) + aoff + m * 2048 + k * 1024); } while (0)
#define PG8_LDB(dst, b, h) do { _Pragma("unroll") for (int n = 0; n < 2; ++n) _Pragma("unroll") for (int k = 0; k < 2; ++k) dst[n][k] = *(const PG8_LAS bf16x8*)(lds + PG8_SB(b, h) + boff + n * 2048 + k * 1024); } while (0)
#define PG8_MMA(ai, bj, At, Bt) do { __builtin_amdgcn_s_setprio(1); _Pragma("unroll") for (int m = 0; m < 4; ++m) _Pragma("unroll") for (int n = 0; n < 2; ++n) _Pragma("unroll") for (int k = 0; k < 2; ++k) \
        acc[ai][bj][m][n] = __builtin_amdgcn_mfma_f32_16x16x32_bf16(Bt[n][k], At[m][k], acc[ai][bj][m][n], 0, 0, 0); __builtin_amdgcn_s_setprio(0); } while (0)
#define PG8_WAIT_V(n) asm volatile("s_waitcnt vmcnt(" #n ")" ::: "memory")
#define PG8_WAIT_L(n) asm volatile("s_waitcnt lgkmcnt(" #n ")" ::: "memory")
#define PG8_BAR __builtin_amdgcn_s_barrier()
#define PG8_SCHED __builtin_amdgcn_sched_barrier(0)
    Unit cur, nxt; int ui = 0;
    if (!S.next(0, cur)) return;
    f32x4 acc[2][2][4][2];
#pragma unroll
    for (int a = 0; a < 2; ++a)
#pragma unroll
        for (int b = 0; b < 2; ++b)
#pragma unroll
            for (int m = 0; m < 4; ++m)
#pragma unroll
                for (int n = 0; n < 2; ++n) acc[a][b][m][n] = (f32x4){0.f, 0.f, 0.f, 0.f};
    bf16x8 At[4][2], B0[2][2], B1[2][2];
    const char* cA = (const char*)g.A + (size_t)cur.pm * tstepA + (size_t)(cur.pn % g.nsplit_n) * pnA + (size_t)(cur.pn / g.nsplit_n) * g.kofs; const char* cB = (const char*)g.Bt + (size_t)(cur.pn % g.nsplit_n) * tstepB + (size_t)(cur.pn / g.nsplit_n) * g.kofs;
    S.a_ready(cur);
    if constexpr (SP2) {
        PG8_STAGE(PG8_SB(0, 0), cB, voffB); PG8_STAGE(PG8_SB(0, 1), cB + hstepB, voffB); PG8_STAGE(PG8_SA(0, 0), cA, voffA); PG8_STAGE(PG8_SA(0, 1), cA + hstepA, voffA);
        if (wr == 1) PG8_BAR;
        PG8_WAIT_V(2); PG8_BAR;
        PG8_STAGE(PG8_SB(1, 0), cB + kstep, voffB); PG8_STAGE(PG8_SA(1, 0), cA + kstep, voffA); PG8_STAGE(PG8_SB(1, 1), cB + hstepB + kstep, voffB);
        PG8_WAIT_V(6); PG8_BAR;
    } else {
        PG8_STAGE(PG8_SB(0, 0), cB, voffB); PG8_STAGE(PG8_SA(0, 0), cA, voffA); PG8_STAGE(PG8_SB(0, 1), cB + hstepB, voffB); PG8_STAGE(PG8_SA(0, 1), cA + hstepA, voffA);
        if (wr == 1) PG8_BAR;
        PG8_WAIT_V(4); PG8_BAR;
        PG8_STAGE(PG8_SB(1, 0), cB + kstep, voffB); PG8_STAGE(PG8_SA(1, 0), cA + kstep, voffA); PG8_STAGE(PG8_SB(1, 1), cB + hstepB + kstep, voffB);
        PG8_WAIT_V(6); PG8_BAR;
    }
    for (;;) {
        const bool has_next = S.next(ui + 1, nxt);
        const char* nA = has_next ? (const char*)g.A + (size_t)nxt.pm * tstepA + (size_t)(nxt.pn % g.nsplit_n) * pnA + (size_t)(nxt.pn / g.nsplit_n) * g.kofs : cA; const char* nB = has_next ? (const char*)g.Bt + (size_t)(nxt.pn % g.nsplit_n) * tstepB + (size_t)(nxt.pn / g.nsplit_n) * g.kofs : cB;
        const bool full_ = (cur.pm != g.half_pm);
        for (int t = 0; t < nt; t += 2) {
            const bool last = (t == nt - 2);
            const char* a1 = cA + (size_t)(t + 1) * kstep;
            const char* a2 = last ? nA : cA + (size_t)(t + 2) * kstep; const char* b2 = last ? nB : cB + (size_t)(t + 2) * kstep;
            const char* a3 = a2 + kstep; const char* b3 = b2 + kstep;
            if (last && has_next) S.a_ready(nxt);
            if constexpr (SP2) {
            PG8_LDB(B0, 0, 0); PG8_LDB(B1, 0, 1); PG8_SCHED; PG8_LDA(At, 0, 0); PG8_STAGE(PG8_SA(1, 1), a1 + hstepA, voffA);
            PG8_WAIT_V(8); PG8_WAIT_L(0); PG8_BAR; PG8_MMA(0, 0, At, B0); PG8_MMA(0, 1, At, B1); PG8_BAR; PG8_SCHED;
            PG8_LDA(At, 0, 1); PG8_STAGE(PG8_SB(0, 0), b2, voffB); PG8_STAGE(PG8_SB(0, 1), b2 + hstepB, voffB); PG8_STAGE(PG8_SA(0, 0), a2, voffA);
            PG8_WAIT_V(8); PG8_WAIT_L(0); PG8_BAR; if (full_) { PG8_MMA(1, 0, At, B0); PG8_MMA(1, 1, At, B1); } PG8_BAR; PG8_SCHED;
            PG8_LDB(B0, 1, 0); PG8_LDB(B1, 1, 1); PG8_SCHED; PG8_LDA(At, 1, 0); PG8_STAGE(PG8_SA(0, 1), a2 + hstepA, voffA);
            PG8_WAIT_V(8); PG8_WAIT_L(0); PG8_BAR; PG8_MMA(0, 0, At, B0); PG8_MMA(0, 1, At, B1); PG8_BAR; PG8_SCHED;
            PG8_LDA(At, 1, 1); PG8_STAGE(PG8_SB(1, 0), b3, voffB); PG8_STAGE(PG8_SB(1, 1), b3 + hstepB, voffB); PG8_STAGE(PG8_SA(1, 0), a3, voffA);
            PG8_WAIT_V(8); PG8_WAIT_L(0); PG8_BAR; if (full_) { PG8_MMA(1, 0, At, B0); PG8_MMA(1, 1, At, B1); } PG8_BAR; PG8_SCHED;
            } else {
            PG8_LDB(B0, 0, 0); PG8_SCHED; PG8_LDA(At, 0, 0); PG8_STAGE(PG8_SA(1, 1), a1 + hstepA, voffA);
            PG8_WAIT_L(8); PG8_BAR; PG8_WAIT_L(0); PG8_MMA(0, 0, At, B0); PG8_BAR; PG8_SCHED;
            PG8_LDB(B1, 0, 1); PG8_STAGE(PG8_SB(0, 0), b2, voffB);
            PG8_BAR; PG8_WAIT_L(0); PG8_MMA(0, 1, At, B1); PG8_BAR;
            PG8_LDA(At, 0, 1); PG8_STAGE(PG8_SA(0, 0), a2, voffA);
            PG8_BAR; PG8_WAIT_L(0); PG8_MMA(1, 0, At, B0); PG8_BAR; PG8_SCHED;
            PG8_STAGE(PG8_SB(0, 1), b2 + hstepB, voffB);
            PG8_WAIT_V(6); PG8_BAR; PG8_MMA(1, 1, At, B1); PG8_BAR;
            PG8_LDB(B0, 1, 0); PG8_SCHED; PG8_LDA(At, 1, 0); PG8_STAGE(PG8_SA(0, 1), a2 + hstepA, voffA);
            PG8_WAIT_L(8); PG8_BAR; PG8_WAIT_L(0); PG8_MMA(0, 0, At, B0); PG8_BAR; PG8_SCHED;
            PG8_LDB(B1, 1, 1); PG8_STAGE(PG8_SB(1, 0), b3, voffB);
            PG8_BAR; PG8_WAIT_L(0); PG8_MMA(0, 1, At, B1); PG8_BAR;
            PG8_LDA(At, 1, 1); PG8_STAGE(PG8_SA(1, 0), a3, voffA);
            PG8_BAR; PG8_WAIT_L(0); PG8_MMA(1, 0, At, B0); PG8_BAR; PG8_SCHED;
            PG8_STAGE(PG8_SB(1, 1), b3 + hstepB, voffB);
            PG8_WAIT_V(6); PG8_BAR; PG8_MMA(1, 1, At, B1); PG8_BAR;
            }
        }
        if constexpr (ALIGN_EPI) { if (wr == 0) PG8_BAR; }
        if constexpr (!Epi::AFTER_DRAIN) { E(acc, cur, wr, wc, fr, fq); S.done(cur); }
        if (!has_next) break;
#pragma unroll
        for (int a = 0; a < 2; ++a)
#pragma unroll
            for (int b = 0; b < 2; ++b)
#pragma unroll
                for (int m = 0; m < 4; ++m)
#pragma unroll
                    for (int n = 0; n < 2; ++n) acc[a][b][m][n] = (f32x4){0.f, 0.f, 0.f, 0.f};
        cur = nxt; cA = nA; cB = nB; ++ui;
        if constexpr (ALIGN_EPI) { if (wr == 1) PG8_BAR; }
    }
    PG8_WAIT_V(0);
    if constexpr (!ALIGN_EPI) { if (wr == 0) PG8_BAR; }
    PG8_BAR;
    if constexpr (Epi::AFTER_DRAIN) { E.fused(acc, cur, wr, wc, fr, fq, lds, wid, lane); S.done(cur); }
#undef PG8_SA
#undef PG8_SB
#undef PG8_STAGE
#undef PG8_LDA
#undef PG8_LDB
#undef PG8_MMA
#undef PG8_WAIT_V
#undef PG8_WAIT_L
#undef PG8_BAR
#undef PG8_SCHED
}
}

using pg8::bf16_t;
#define LAS __attribute__((address_space(3)))
#define GAS __attribute__((address_space(1)))
typedef float f32x4 __attribute__((ext_vector_type(4)));
typedef float f32x16 __attribute__((ext_vector_type(16)));
typedef short bf16x8 __attribute__((ext_vector_type(8)));
typedef short s16x4 __attribute__((ext_vector_type(4)));
typedef unsigned u32x4 __attribute__((ext_vector_type(4)));
typedef unsigned u32x2 __attribute__((ext_vector_type(2)));

constexpr int T_ = 4112, NB = 8, M_ = NB * T_, MP = 33024, D_ = 1024, NTHR = 512, NWV = 8;
constexpr float EPS = 1e-6f;
constexpr float QSCALE = 0.10206207261596577f * 1.4426950408889634f;
constexpr size_t MiB = 1u << 20;
constexpr size_t WS_CTL = 0, CTL_BYTES = 32768, WS_SSQM = 7 * MiB + 512 * 1024;
constexpr size_t WS_M = 10 * MiB;
constexpr size_t WS_SSQS = 75 * MiB;
constexpr size_t WS_COS = 1 * MiB, WS_SIN = 1 * MiB + 512 * 1024;
constexpr size_t WS_RSTDH = 2 * MiB, WS_RSTDQ = 2 * MiB + 256 * 1024, WS_RSTDKV = 2 * MiB + 512 * 1024;
constexpr size_t WS_DT = 3 * MiB, WS_KR = 5 * MiB + 256 * 1024, WS_SL = 3 * MiB, WS_SB = 4 * MiB + 512 * 1024;
constexpr size_t WS_H = 10 * MiB, WS_HB = 139 * MiB, WS_R = 203 * MiB + 512 * 1024;
constexpr size_t R_AB = 0, R_LAT = 129 * MiB, R_KV = 177 * MiB + 512 * 1024;
constexpr size_t R_U = 0;
constexpr size_t R_X = 0, R_G = 81 * MiB, R_XR = 162 * MiB;
constexpr size_t WS_NEED = WS_R + R_KV + 129 * MiB;
constexpr size_t WS_W = 80 * MiB;
constexpr size_t DO_Q = 30 * MiB;
constexpr size_t WS_PART = 112 * MiB;
constexpr size_t W_IN = 0, W_Q = 6 * MiB + 512 * 1024, W_KV = 7 * MiB + 640 * 1024, W_O = 8 * MiB + 640 * 1024, W_UP = 12 * MiB + 640 * 1024, W_DN = 20 * MiB + 640 * 1024;
constexpr size_t W_XY = 0, W_AI = 5 * MiB, W_RO = 5 * MiB + 640 * 1024;
constexpr int LDS_BYTES = 147456, LDS_CTL = 147200;

__device__ __forceinline__ unsigned xcc_id_() { return (unsigned)__builtin_amdgcn_s_getreg((3 << 11) | 20) & 0xFu; }
struct Params { const float* in[30]; float* out; unsigned char* ws; };
typedef const __attribute__((address_space(4))) unsigned char* PTAB;
__device__ __forceinline__ void* ldptr(PTAB kp, int k) { unsigned long long v = *(volatile const __attribute__((address_space(4))) unsigned long long*)(kp + 8 * k); asm volatile("" : "+s"(v)); return (void*)v; }
#define INP(k) ((const float*)ldptr(ptab, (k)))
#define OUTB ((unsigned char*)ldptr(ptab, 30))
#define WSP ((unsigned char*)ldptr(ptab, 31))

__device__ __forceinline__ float bflo(unsigned u) { return __uint_as_float(u << 16); }
__device__ __forceinline__ float bfhi(unsigned u) { return __uint_as_float(u & 0xffff0000u); }
__device__ __forceinline__ float bf1(bf16_t b) { return __uint_as_float((unsigned)b << 16); }
__device__ __forceinline__ unsigned pk2(float lo, float hi) {
    typedef float f2_t __attribute__((ext_vector_type(2))); typedef __bf16 b2_t __attribute__((ext_vector_type(2)));
    f2_t v = {lo, hi}; b2_t b = __builtin_convertvector(v, b2_t); return __builtin_bit_cast(unsigned, b); }
__device__ __forceinline__ float sigmoidf_(float x) { return __builtin_amdgcn_rcpf(1.0f + __expf(-x)); }
__device__ __forceinline__ float siluf_(float x) { return x * sigmoidf_(x); }
__device__ __forceinline__ float softplusf_(float x) { return x > 20.f ? x : __logf(1.0f + __expf(x)); }
__device__ __forceinline__ float gelu_tanh(float x) { const float y = 1.5957691216057308f * (x + 0.044715f * x * x * x); return x * __builtin_amdgcn_rcpf(1.0f + __expf(-y)); }
__device__ __forceinline__ float wave_sum(float v) {
#pragma unroll
    for (int o = 1; o < 64; o <<= 1) v += __shfl_xor(v, o);
    return v;
}
template <int CTRL> __device__ __forceinline__ float dpp_f(float v) { return __int_as_float(__builtin_amdgcn_update_dpp(0, __float_as_int(v), CTRL, 0xF, 0xF, true)); }
__device__ __forceinline__ float sum16(float v) { v += dpp_f<0xB1>(v); v += dpp_f<0x4E>(v); v += dpp_f<0x141>(v); v += dpp_f<0x140>(v); return v; }
__device__ __forceinline__ float sum8(float v) { v += dpp_f<0xB1>(v); v += dpp_f<0x4E>(v); v += dpp_f<0x141>(v); return v; }

enum { EP_IN = 0, EP_Q, EP_KV, EP_M, EP_UP, EP_XY, EP_AI, EP_PART };
template <int MODE> struct Epi {
    static constexpr bool PERM = true, AFTER_DRAIN = false;
    const float* rs; bf16_t* o0; bf16_t* o1; bf16_t* o2; float* ssq; const float* c0; const float* c1; const float* c2; const bf16_t* xr;
    __device__ __forceinline__ void operator()(const f32x4 (&acc)[2][2][4][2], const pg8::Unit& u, int wr, int wc, int fr, int fq) const {
        const int cw = wc * 32 + 8 * fq;
        float ai_ba[8], ai_bi[8], ai_sp[8];
        if constexpr (MODE == EP_AI) {
            const int ch = u.pn * 128 + cw;
#pragma unroll
            for (int e = 0; e < 8; ++e) { ai_ba[e] = *(const GAS float*)(c0 + ch + e); ai_bi[e] = *(const GAS float*)(c1 + ch + e); ai_sp[e] = -8.0f * softplusf_(-*(const GAS float*)(c2 + ch + e)); }
        }
        float scv[8];
        if constexpr (MODE == EP_IN || MODE == EP_KV || MODE == EP_UP || MODE == EP_XY || MODE == EP_Q) {
#pragma unroll
            for (int k = 0; k < 8; ++k) scv[k] = *(const GAS float*)(rs + u.pm * 256 + (k >> 2) * 128 + wr * 64 + (k & 3) * 16 + fr);
        }
#pragma unroll
        for (int ai = 0; ai < 2; ++ai) {
            u32x4 ai_xv[4];
            if constexpr (MODE == EP_AI) {
#pragma unroll
                for (int k = 0; k < 4; ++k) ai_xv[k] = *(const GAS u32x4*)(xr + (size_t)(u.pm * 256 + ai * 128 + wr * 64 + k * 16 + fr) * 1280 + u.pn * 128 + cw);
            }
#pragma unroll
            for (int m = 0; m < 4; ++m) {
                const int row = u.pm * 256 + ai * 128 + wr * 64 + m * 16 + fr;
                if constexpr (MODE == EP_PART) {
                    if (ai == 0) { GAS float* pp = (GAS float*)c0 + ((size_t)((u.pn >> 2) * 128 + wr * 64 + m * 16 + fr)) * 1024 + (u.pn & 3) * 256 + cw;
#pragma unroll
                        for (int bj = 0; bj < 2; ++bj) { *(GAS f32x4*)(pp + bj * 128) = acc[ai][bj][m][0]; *(GAS f32x4*)(pp + bj * 128 + 4) = acc[ai][bj][m][1]; } }
                } else
                if constexpr (MODE == EP_AI) {
                    const int ch = u.pn * 128 + cw;
                    const u32x4 xv = ai_xv[m];
                    const float xf[8] = {bflo(xv.x), bfhi(xv.x), bflo(xv.y), bfhi(xv.y), bflo(xv.z), bfhi(xv.z), bflo(xv.w), bfhi(xv.w)};
                    float la[8], uu[8];
#pragma unroll
                    for (int e = 0; e < 8; ++e) {
                        const float rp = acc[ai][0][m][e >> 2][e & 3] + ai_ba[e], ip = acc[ai][1][m][e >> 2][e & 3] + ai_bi[e];
                        const float r = sigmoidf_(rp), ig = sigmoidf_(ip);
                        const float l = r * ai_sp[e];
                        la[e] = l; uu[e] = __builtin_amdgcn_sqrtf(fmaxf(1.0f - __expf(2.0f * l), 0.f)) * (ig * xf[e]);
                    }
                    u32x4 w; w.x = pk2(la[0], la[1]); w.y = pk2(la[2], la[3]); w.z = pk2(la[4], la[5]); w.w = pk2(la[6], la[7]);
                    *(GAS u32x4*)(o0 + (size_t)row * 1280 + ch) = w;
                    w.x = pk2(uu[0], uu[1]); w.y = pk2(uu[2], uu[3]); w.z = pk2(uu[4], uu[5]); w.w = pk2(uu[6], uu[7]);
                    *(GAS u32x4*)(o1 + (size_t)row * 1280 + ch) = w;
                } else {
                    float sc = 1.0f;
                    if constexpr (MODE == EP_IN || MODE == EP_KV || MODE == EP_UP || MODE == EP_XY) sc = scv[ai * 4 + m];
                    if constexpr (MODE == EP_Q) sc = scv[ai * 4 + m] * QSCALE;
                    float sq = 0.f;
#pragma unroll
                    for (int bj = 0; bj < 2; ++bj) {
                        f32x4 v0 = acc[ai][bj][m][0] * sc, v1 = acc[ai][bj][m][1] * sc;
                        const int col = u.pn * 256 + bj * 128 + cw;
                        bf16_t* dst;
                        if constexpr (MODE == EP_IN) {
                            if (u.pn < 4) dst = o0 + (size_t)row * 2048 + col; else if (u.pn < 10) dst = o1 + (size_t)row * 1536 + (col - 1024); else dst = o2 + (size_t)row * 768 + (col - 2560);
                        } else if constexpr (MODE == EP_Q) {
                            dst = o0 + (size_t)row * 1536 + col;
                            const int d = col % 96;
                            if (d >= 64) {
                                const int t = row % T_, i0 = (d - 64) >> 1;
                                const f32x4 c = *(const GAS f32x4*)(c0 + t * 16 + i0), s = *(const GAS f32x4*)(c1 + t * 16 + i0);
                                const f32x4 a0 = v0, a1 = v1;
                                v0[0] = a0[0] * c[0] - a0[1] * s[0]; v0[1] = a0[1] * c[0] + a0[0] * s[0];
                                v0[2] = a0[2] * c[1] - a0[3] * s[1]; v0[3] = a0[3] * c[1] + a0[2] * s[1];
                                v1[0] = a1[0] * c[2] - a1[1] * s[2]; v1[1] = a1[1] * c[2] + a1[0] * s[2];
                                v1[2] = a1[2] * c[3] - a1[3] * s[3]; v1[3] = a1[3] * c[3] + a1[2] * s[3];
                            }
                        } else if constexpr (MODE == EP_KV) { dst = o0 + (size_t)row * 2048 + col;
                        } else if constexpr (MODE == EP_M) { dst = o0 + (size_t)row * 1024 + col;
                            sq += (v0[0] * v0[0] + v0[1] * v0[1]) + (v0[2] * v0[2] + v0[3] * v0[3]) + (v1[0] * v1[0] + v1[1] * v1[1]) + (v1[2] * v1[2] + v1[3] * v1[3]);
                        } else if constexpr (MODE == EP_UP) { dst = o0 + (size_t)row * 4096 + col;
#pragma unroll
                            for (int e = 0; e < 4; ++e) { const float a = fmaxf(v0[e], 0.f), b = fmaxf(v1[e], 0.f); v0[e] = a * a; v1[e] = b * b; }
                        } else {
                            if (u.pn < 5) dst = o0 + (size_t)row * 1280 + col;
                            else { dst = o1 + (size_t)row * 1280 + (col - 1280);
#pragma unroll
                                for (int e = 0; e < 4; ++e) { v0[e] = gelu_tanh(v0[e]); v1[e] = gelu_tanh(v1[e]); } }
                        }
                        u32x4 w; w.x = pk2(v0[0], v0[1]); w.y = pk2(v0[2], v0[3]); w.z = pk2(v1[0], v1[1]); w.w = pk2(v1[2], v1[3]);
                        if constexpr (MODE == EP_UP) __builtin_nontemporal_store(w, (GAS u32x4*)dst);
                        else *(GAS u32x4*)dst = w;
                    }
                    if constexpr (MODE == EP_M) {
                        sq += __shfl_xor(sq, 16); sq += __shfl_xor(sq, 32);
                        if (fq == 0) *(GAS float*)(ssq + (size_t)row * 16 + u.pn * 4 + wc) = sq;
                    }
                }
            }
        }
    }
};

struct TailOrder {
    int nN, G, c, pm;
    __device__ bool next(int i, pg8::Unit& u) const { const int pn = i * G + c; if (pn >= nN) return false; u.pm = pm; u.pn = pn; return true; }
    __device__ __forceinline__ void a_ready(const pg8::Unit&) const {}
    __device__ __forceinline__ void done(const pg8::Unit&) const {}
};
template <int MODE, int PART = 0> __device__ __forceinline__ void run_gemm(int wv_, LAS unsigned char* lds, const bf16_t* A, int lda, int a_pn, const bf16_t* Bt, int N, int K, const Epi<MODE>& E) {
    pg8::Gemm g{A, Bt, MP, N, K, lda, K, a_pn, MP / 256 - 1, 1 << 20, 0};
    int bid_ = __builtin_amdgcn_readfirstlane((int)*(volatile LAS unsigned*)(lds + LDS_CTL + 128)), gdim_ = (int)gridDim.x; asm volatile("" : "+s"(bid_), "+s"(gdim_));
    if constexpr (PART == 2) { TailOrder S{N / 256, gdim_, bid_, MP / 256 - 1}; pg8::gemm_phase<Epi<MODE>, TailOrder, true, true>(wv_, lds, g, S, E); }
    else { pg8::StaticOrder S; S.init(PART == 1 ? MP - 256 : MP, N, gdim_, bid_); pg8::gemm_phase<Epi<MODE>, pg8::StaticOrder, true, true>(wv_, lds, g, S, E); }
}

template <int MODE> __device__ __forceinline__ void run_gemm_tail(int wv_, LAS unsigned char* lds, const bf16_t* A, int lda, const bf16_t* Bt, int ldb, int ksz, int nks, const Epi<MODE>& E) {
    pg8::Gemm g{A, Bt, MP, 1024, ksz, lda, ldb, 0, MP / 256 - 1, 4, ksz * 2};
    int bid_ = __builtin_amdgcn_readfirstlane((int)*(volatile LAS unsigned*)(lds + LDS_CTL + 128)), gdim_ = (int)gridDim.x; asm volatile("" : "+s"(bid_), "+s"(gdim_));
    TailOrder S{4 * nks, gdim_, bid_, MP / 256 - 1}; pg8::gemm_phase<Epi<MODE>, TailOrder, true, true>(wv_, lds, g, S, E);
}

__device__ __forceinline__ int cmap(int kind, int n) {
    if (kind == 0) return n;
    if (kind == 1) {
        if (n < 2560) return n;
        const int j = n - 2560;
        if (j < 384) return 2576 + j;
        if (j < 640) return 2960 + (j - 384);
        if (j < 672) { const int i = (j - 640) >> 1; return (j & 1) ? 3216 + 16 + i : 3216 + i; }
        if (j < 688) return 2560 + (j - 672);
        return -1;
    }
    const int h = n / 96, d = n % 96;
    if (d < 64) return n;
    const int i = (d - 64) >> 1;
    return h * 96 + 64 + ((d & 1) ? 16 + i : i);
}
__device__ __forceinline__ void cvt_item(const float* W, int K, int Ns, bf16_t* WT, int row_off, int Nd, int kind, const float* g, int glim, LAS float* scr, int item, int lane) {
    const int nblk = Nd / 32, kb = item / nblk, nb = item % nblk, k0 = 64 * kb, n0 = 32 * nb;
    const int sc = cmap(kind, n0 + (lane & 31));
    {
        const int scc = sc >= 0 ? sc : 0; float wv32[32], gv32[32];
        const GAS float* wp = (const GAS float*)W + (size_t)(k0 + (lane >> 5)) * Ns + scc;
#pragma unroll
        for (int i = 0; i < 32; ++i) wv32[i] = wp[(size_t)(2 * i) * Ns];
#pragma unroll
        for (int i = 0; i < 32; ++i) { const int kk = k0 + 2 * i + (lane >> 5); gv32[i] = (g && kk < glim) ? *(const GAS float*)(g + kk) : 1.0f; }
#pragma unroll
        for (int i = 0; i < 32; ++i) { const int kk = 2 * i + (lane >> 5); scr[kk * 33 + (lane & 31)] = sc >= 0 ? wv32[i] * gv32[i] : 0.f; }
    }
    asm volatile("s_waitcnt lgkmcnt(0)" ::: "memory");
    const int c = lane & 7;
#pragma unroll
    for (int j = 0; j < 4; ++j) { const int n = (lane >> 3) + 8 * j; const LAS float* s = scr + (8 * c) * 33 + n;
        u32x4 o; o.x = pk2(s[0 * 33], s[1 * 33]); o.y = pk2(s[2 * 33], s[3 * 33]); o.z = pk2(s[4 * 33], s[5 * 33]); o.w = pk2(s[6 * 33], s[7 * 33]);
        *(u32x4*)(WT + (size_t)(row_off + n0 + n) * K + k0 + 8 * c) = o; }
    asm volatile("s_waitcnt lgkmcnt(0)" ::: "memory");
}
__device__ __forceinline__ void convert_layer(PTAB ptab, int wv_, int L, LAS unsigned char* lds) {
    const int lane = tid_opaque() & 63, wave = tid_opaque() >> 6;
    LAS float* scr = (LAS float*)(lds + wave * 16384);
    const int NGW = gridDim.x * NWV; int it = blockIdx.x * NWV + wave;
    bf16_t* W = (bf16_t*)(WSP + WS_W);
#define JOB(Wp, K, Ns, dstoff, roff, Nd, kind, g, glim) { const int ni_ = ((K) / 64) * ((Nd) / 32); for (; it < ni_; it += NGW) cvt_item((Wp), (K), (Ns), (bf16_t*)((unsigned char*)W + (dstoff)), (roff), (Nd), (kind), (g), (glim), scr, it, lane); it -= ni_; }
    if ((L & 1) == 0) {
        const int e = L >> 1;
        JOB(INP(8) + (size_t)e * 1024 * 3248, 1024, 3248, W_IN, 0, 3328, 1, INP(2) + L * 1024, 1024);
        JOB(INP(16) + (size_t)e * 384 * 1536, 384, 1536, W_Q, 0, 1536, 2, INP(15) + e * 384, 384);
        JOB(INP(18) + (size_t)e * 256 * 2048, 256, 2048, W_KV, 0, 2048, 0, INP(17) + e * 256, 256);
        JOB(INP(19) + (size_t)e * 2048 * 1024, 2048, 1024, W_O, 0, 1024, 0, INP(14) + e * 1024, 1024);
    } else {
        const int o = L >> 1;
        JOB(INP(20) + (size_t)o * 1024 * 1280, 1024, 1280, W_XY, 0, 1280, 0, INP(2) + L * 1024, 1024);
        JOB(INP(21) + (size_t)o * 1024 * 1280, 1024, 1280, W_XY, 1280, 1280, 0, INP(2) + L * 1024, 1024);
        for (int blk = 0; blk < 10; ++blk) {
            JOB(INP(24) + (size_t)(o * 10 + blk) * 128 * 128, 128, 128, W_AI, blk * 256, 128, 0, (const float*)nullptr, 0);
            JOB(INP(26) + (size_t)(o * 10 + blk) * 128 * 128, 128, 128, W_AI, blk * 256 + 128, 128, 0, (const float*)nullptr, 0);
        }
        JOB(INP(29) + (size_t)o * 1280 * 1024, 1280, 1024, W_RO, 0, 1024, 0, (const float*)nullptr, 0);
    }
    JOB(INP(6) + (size_t)L * 1024 * 4096, 1024, 4096, W_UP, 0, 4096, 0, INP(4) + L * 1024, 1024);
    JOB(INP(7) + (size_t)L * 4096 * 1024, 4096, 1024, W_DN, 0, 1024, 0, (const float*)nullptr, 0);
#undef JOB
}

__device__ __forceinline__ void setup_rows(PTAB ptab, int wv_) {
    const int lane = tid_opaque() & 63, gw = blockIdx.x * NWV + (tid_opaque() >> 6), NGW = gridDim.x * NWV;
    bf16_t* HB = (bf16_t*)(WSP + WS_HB); float* rstd = (float*)(WSP + WS_RSTDH);
    for (int row = gw; row < MP; row += NGW) {
        f32x4 v[4]; float s = 0.f;
        const float* src = nullptr;
        if (row < M_) { const int b = row / T_, t = row % T_; src = t < 16 ? INP(1) + (size_t)t * D_ : INP(0) + ((size_t)b * 4096 + (t - 16)) * D_; }
#pragma unroll
        for (int j = 0; j < 4; ++j) { v[j] = src ? *(const f32x4*)(src + 4 * lane + 256 * j) : (f32x4){0.f, 0.f, 0.f, 0.f}; s += (v[j][0] * v[j][0] + v[j][1] * v[j][1]) + (v[j][2] * v[j][2] + v[j][3] * v[j][3]); }
        s = wave_sum(s);
#pragma unroll
        for (int j = 0; j < 4; ++j) {
            u32x2 w; w.x = pk2(v[j][0], v[j][1]); w.y = pk2(v[j][2], v[j][3]); *(u32x2*)(HB + (size_t)row * D_ + 4 * lane + 256 * j) = w; }
        if (lane == 0) rstd[row] = __builtin_amdgcn_rsqf(s * (1.0f / D_) + EPS);
    }
    float* ct = (float*)(WSP + WS_COS); float* st = (float*)(WSP + WS_SIN);
    for (int i = blockIdx.x * NTHR + tid_opaque(); i < T_ * 16; i += gridDim.x * NTHR) {
        const int t = i >> 4, k = i & 15; const float inv = powf(10000.0f, -(float)(2 * k) / 32.0f); const float ang = (float)t * inv;
        ct[i] = cosf(ang); st[i] = sinf(ang);
    }
}
__device__ __forceinline__ void resnorm_phase(PTAB ptab, int wv_, LAS unsigned char* lds, const float* gpost, bool last, int r0, int r1, int cu_lo, bool dry = false) {
    const int vcu_ = __builtin_amdgcn_readfirstlane((int)*(volatile LAS unsigned*)(lds + LDS_CTL + 128));
    if (vcu_ < cu_lo) return;
    const int lane = tid_opaque() & 63, gw = (vcu_ - cu_lo) * NWV + (tid_opaque() >> 6), NGW = ((int)gridDim.x - cu_lo) * NWV;
    const GAS bf16_t* MB = (const GAS bf16_t*)(WSP + WS_M); GAS bf16_t* HB = (GAS bf16_t*)(WSP + WS_HB); GAS float* rstd = (GAS float*)(WSP + WS_RSTDH); const GAS float* ssq = (const GAS float*)(WSP + WS_SSQM);
    const GAS float* gp = (const GAS float*)gpost; GAS float* outp = (GAS float*)OUTB;
    f32x4 g[4];
#pragma unroll
    for (int j = 0; j < 4; ++j) g[j] = *(const GAS f32x4*)(gp + 4 * lane + 256 * j);
    constexpr int RB = 4;
    for (int row0 = r0 + gw; row0 < r1; row0 += RB * NGW) {
        u32x2 hb[RB][4], mb[RB][4]; float pq[RB];
#pragma unroll
        for (int q = 0; q < RB; ++q) { int row = row0 + q * NGW; row = row < r1 ? row : row0;
            pq[q] = lane < 16 ? ssq[(size_t)row * 16 + lane] : 0.f;
#pragma unroll
            for (int j = 0; j < 4; ++j) { const int c = 4 * lane + 256 * j; hb[q][j] = *(const GAS u32x2*)(HB + (size_t)row * D_ + c); mb[q][j] = *(const GAS u32x2*)(MB + (size_t)row * D_ + c); } }
#pragma unroll
        for (int q = 0; q < RB; ++q) { const int row = row0 + q * NGW;
            if (row < r1) {
                const float rm = __builtin_amdgcn_rsqf(wave_sum(pq[q]) * (1.0f / D_) + EPS);
                f32x4 v[4]; float sq = 0.f;
#pragma unroll
                for (int j = 0; j < 4; ++j) {
                    v[j][0] = bflo(hb[q][j].x) + bflo(mb[q][j].x) * rm * g[j][0]; v[j][1] = bfhi(hb[q][j].x) + bfhi(mb[q][j].x) * rm * g[j][1];
                    v[j][2] = bflo(hb[q][j].y) + bflo(mb[q][j].y) * rm * g[j][2]; v[j][3] = bfhi(hb[q][j].y) + bfhi(mb[q][j].y) * rm * g[j][3];
                    sq += (v[j][0] * v[j][0] + v[j][1] * v[j][1]) + (v[j][2] * v[j][2] + v[j][3] * v[j][3]); }
                sq = wave_sum(sq);
                if (dry) { if (sq == 12345.678f) rstd[row] = sq; }
                else if (!last) {
#pragma unroll
                    for (int j = 0; j < 4; ++j) { const int c = 4 * lane + 256 * j;
                        u32x2 w; w.x = pk2(v[j][0], v[j][1]); w.y = pk2(v[j][2], v[j][3]); *(GAS u32x2*)(HB + (size_t)row * D_ + c) = w; }
                    if (lane == 0) rstd[row] = __builtin_amdgcn_rsqf(sq * (1.0f / D_) + EPS);
                } else if (row < M_) {
                    const int b = row / T_, t = row % T_;
                    if (t >= 16) {
#pragma unroll
                        for (int j = 0; j < 4; ++j) *(GAS f32x4*)(outp + ((size_t)b * 4096 + (t - 16)) * D_ + 4 * lane + 256 * j) = v[j];
                    }
                }
            }
        }
    }
}
__device__ __forceinline__ void tail_reduce_resnorm(PTAB ptab, int wv_, const float* gpost, bool last, int nks) {
    const int lane = tid_opaque() & 63, gw = blockIdx.x * NWV + (tid_opaque() >> 6), NGW = gridDim.x * NWV;
    const GAS float* PART = (const GAS float*)(WSP + WS_PART); GAS bf16_t* HB = (GAS bf16_t*)(WSP + WS_HB); GAS float* rstd = (GAS float*)(WSP + WS_RSTDH);
    const GAS float* gp = (const GAS float*)gpost; GAS float* outp = (GAS float*)OUTB;
    for (int r = gw; r < 128; r += NGW) {
        const int row = MP - 256 + r;
        f32x4 m[4]; u32x2 hb[4]; f32x4 g[4];
#pragma unroll
        for (int j = 0; j < 4; ++j) { const int c = 4 * lane + 256 * j; m[j] = *(const GAS f32x4*)(PART + (size_t)r * 1024 + c); hb[j] = *(const GAS u32x2*)(HB + (size_t)row * D_ + c); g[j] = *(const GAS f32x4*)(gp + c); }
        for (int ks = 1; ks < nks; ++ks) {
#pragma unroll
            for (int j = 0; j < 4; ++j) m[j] += *(const GAS f32x4*)(PART + ((size_t)ks * 128 + r) * 1024 + 4 * lane + 256 * j); }
        float pq = 0.f;
#pragma unroll
        for (int j = 0; j < 4; ++j) pq += (m[j][0] * m[j][0] + m[j][1] * m[j][1]) + (m[j][2] * m[j][2] + m[j][3] * m[j][3]);
        const float rm = __builtin_amdgcn_rsqf(wave_sum(pq) * (1.0f / D_) + EPS);
        f32x4 v[4]; float sq = 0.f;
#pragma unroll
        for (int j = 0; j < 4; ++j) {
            v[j][0] = bflo(hb[j].x) + m[j][0] * rm * g[j][0]; v[j][1] = bfhi(hb[j].x) + m[j][1] * rm * g[j][1]; v[j][2] = bflo(hb[j].y) + m[j][2] * rm * g[j][2]; v[j][3] = bfhi(hb[j].y) + m[j][3] * rm * g[j][3];
            sq += (v[j][0] * v[j][0] + v[j][1] * v[j][1]) + (v[j][2] * v[j][2] + v[j][3] * v[j][3]); }
        sq = wave_sum(sq);
        if (!last) {
#pragma unroll
            for (int j = 0; j < 4; ++j) { u32x2 w; w.x = pk2(v[j][0], v[j][1]); w.y = pk2(v[j][2], v[j][3]); *(GAS u32x2*)(HB + (size_t)row * D_ + 4 * lane + 256 * j) = w; }
            if (lane == 0) rstd[row] = __builtin_amdgcn_rsqf(sq * (1.0f / D_) + EPS);
        } else {
            const int b = row / T_, t = row % T_;
#pragma unroll
            for (int j = 0; j < 4; ++j) *(GAS f32x4*)(outp + ((size_t)b * 4096 + (t - 16)) * D_ + 4 * lane + 256 * j) = v[j];
        }
    }
}
template <bool SILU> __device__ __forceinline__ void conv_pass(int wv_, const bf16_t* Xg, int ncols, const float* cwg, const float* cbg, bf16_t* Og) {
    const GAS bf16_t* X = (const GAS bf16_t*)Xg; GAS bf16_t* O = (GAS bf16_t*)Og; const GAS float* cw = (const GAS float*)cwg; const GAS float* cb = (const GAS float*)cbg;
    const int nchunk = ncols >> 3; constexpr int RUN = 48;
    for (int it = blockIdx.x * NTHR + tid_opaque(); it < nchunk * (MP / RUN); it += gridDim.x * NTHR) {
        const int c = (it % nchunk) * 8, r0 = (it / nchunk) * RUN;
        float w[4][8], bia[8];
#pragma unroll
        for (int i = 0; i < 4; ++i) { const f32x4 a = *(const GAS f32x4*)(cw + i * ncols + c), b = *(const GAS f32x4*)(cw + i * ncols + c + 4);
            w[i][0] = a[0]; w[i][1] = a[1]; w[i][2] = a[2]; w[i][3] = a[3]; w[i][4] = b[0]; w[i][5] = b[1]; w[i][6] = b[2]; w[i][7] = b[3]; }
        { const f32x4 a = *(const GAS f32x4*)(cb + c), b = *(const GAS f32x4*)(cb + c + 4); bia[0] = a[0]; bia[1] = a[1]; bia[2] = a[2]; bia[3] = a[3]; bia[4] = b[0]; bia[5] = b[1]; bia[6] = b[2]; bia[7] = b[3]; }
        u32x4 x1, x2, x3;
        { const int ra = r0 - 1 > 0 ? r0 - 1 : 0, rb = r0 - 2 > 0 ? r0 - 2 : 0, rc = r0 - 3 > 0 ? r0 - 3 : 0;
          x1 = *(const GAS u32x4*)(X + (size_t)ra * ncols + c); x2 = *(const GAS u32x4*)(X + (size_t)rb * ncols + c); x3 = *(const GAS u32x4*)(X + (size_t)rc * ncols + c); }
        for (int rr = 0; rr < RUN; rr += 4) {
            u32x4 xn[4];
#pragma unroll
            for (int k = 0; k < 4; ++k) xn[k] = *(const GAS u32x4*)(X + (size_t)(r0 + rr + k) * ncols + c);
#pragma unroll
            for (int k = 0; k < 4; ++k) {
                const int row = r0 + rr + k, t = row % T_;
                const float m1 = t >= 1 ? 1.f : 0.f, m2 = t >= 2 ? 1.f : 0.f, m3 = t >= 3 ? 1.f : 0.f;
                const u32x4 x0 = xn[k]; float a[8];
#define CV_(e, f0, f1, f2, f3) a[e] = bia[e] + w[3][e] * (f0) + m1 * (w[2][e] * (f1)) + m2 * (w[1][e] * (f2)) + m3 * (w[0][e] * (f3))
                CV_(0, bflo(x0.x), bflo(x1.x), bflo(x2.x), bflo(x3.x)); CV_(1, bfhi(x0.x), bfhi(x1.x), bfhi(x2.x), bfhi(x3.x));
                CV_(2, bflo(x0.y), bflo(x1.y), bflo(x2.y), bflo(x3.y)); CV_(3, bfhi(x0.y), bfhi(x1.y), bfhi(x2.y), bfhi(x3.y));
                CV_(4, bflo(x0.z), bflo(x1.z), bflo(x2.z), bflo(x3.z)); CV_(5, bfhi(x0.z), bfhi(x1.z), bfhi(x2.z), bfhi(x3.z));
                CV_(6, bflo(x0.w), bflo(x1.w), bflo(x2.w), bflo(x3.w)); CV_(7, bfhi(x0.w), bfhi(x1.w), bfhi(x2.w), bfhi(x3.w));
#undef CV_
                if (SILU) {
#pragma unroll
                    for (int e2 = 0; e2 < 8; ++e2) a[e2] = siluf_(a[e2]); }
                u32x4 o; o.x = pk2(a[0], a[1]); o.y = pk2(a[2], a[3]); o.z = pk2(a[4], a[5]); o.w = pk2(a[6], a[7]);
                *(GAS u32x4*)(O + (size_t)row * ncols + c) = o;
                x3 = x2; x2 = x1; x1 = x0;
            }
        }
    }
}
__device__ __forceinline__ void prep_phase(PTAB ptab, int wv_, int e) {
    const int lane = tid_opaque() & 63, gw = blockIdx.x * NWV + (tid_opaque() >> 6), NGW = gridDim.x * NWV;
    const bf16_t* LAT = (const bf16_t*)(WSP + WS_R + R_LAT);
    float* rq = (float*)(WSP + WS_RSTDQ); float* rkv = (float*)(WSP + WS_RSTDKV); float* DT = (float*)(WSP + WS_DT); bf16_t* KR = (bf16_t*)(WSP + WS_KR);
    const float* ct = (const float*)(WSP + WS_COS); const float* st = (const float*)(WSP + WS_SIN);
    const float* dtb = INP(11) + e * 16;
    for (int row0 = gw; row0 < MP; row0 += 4 * NGW) {
        unsigned wq[4][3], wk[4][2], wx[4];
#pragma unroll
        for (int q = 0; q < 4; ++q) { int row = row0 + q * NGW; row = row < MP ? row : row0; const GAS bf16_t* lr = (const GAS bf16_t*)LAT + (size_t)row * 768;
#pragma unroll
            for (int j = 0; j < 3; ++j) wq[q][j] = *(const GAS unsigned*)(lr + 2 * lane + 128 * j);
#pragma unroll
            for (int j = 0; j < 2; ++j) wk[q][j] = *(const GAS unsigned*)(lr + 384 + 2 * lane + 128 * j);
            wx[q] = *(const GAS unsigned*)(lr + 640 + 2 * (lane & 31)); }
#pragma unroll
        for (int q = 0; q < 4; ++q) { const int row = row0 + q * NGW;
            if (row < MP) {
                float sq = 0.f, sk = 0.f;
#pragma unroll
                for (int j = 0; j < 3; ++j) { const float a = bflo(wq[q][j]), b = bfhi(wq[q][j]); sq += a * a + b * b; }
#pragma unroll
                for (int j = 0; j < 2; ++j) { const float a = bflo(wk[q][j]), b = bfhi(wk[q][j]); sk += a * a + b * b; }
                sq = wave_sum(sq); sk = wave_sum(sk);
                if (lane == 0) { *(GAS float*)(rq + row) = __builtin_amdgcn_rsqf(sq * (1.0f / 384.f) + EPS); *(GAS float*)(rkv + row) = __builtin_amdgcn_rsqf(sk * (1.0f / 256.f) + EPS); }
                const int t = row % T_;
                if (lane < 16) { const float x1 = bflo(wx[q]), x2 = bfhi(wx[q]), c = *(const GAS float*)(ct + t * 16 + lane), sn = *(const GAS float*)(st + t * 16 + lane);
                    *(GAS unsigned*)(KR + (size_t)row * 32 + 2 * lane) = pk2(x1 * c - x2 * sn, x2 * c + x1 * sn); }
                else if (lane < 24) { const int h2 = 2 * (lane - 16);
                    *(GAS float*)(DT + (size_t)row * 16 + h2) = softplusf_(bflo(wx[q]) + *(const GAS float*)(dtb + h2)); *(GAS float*)(DT + (size_t)row * 16 + h2 + 1) = softplusf_(bfhi(wx[q]) + *(const GAS float*)(dtb + h2 + 1)); }
            }
        }
    }
    conv_pass<true>(wv_, (const bf16_t*)(WSP + WS_R + R_KV), 1536, INP(9) + (size_t)e * 4 * 1536, INP(10) + (size_t)e * 1536, (bf16_t*)(OUTB + DO_Q));
}
__device__ __forceinline__ void fix_phase(PTAB ptab, int wv_, bool dry = false) {
    const int lane = tid_opaque() & 63, gw = blockIdx.x * NWV + (tid_opaque() >> 6), NGW = gridDim.x * NWV;
    bf16_t* AB = (bf16_t*)(WSP + WS_R + R_AB); float* ssq = (float*)(WSP + WS_SSQS);
    for (int row0 = gw; row0 < MP; row0 += 4 * NGW) {
        float pq[4]; u32x4 v[4][2];
#pragma unroll
        for (int q = 0; q < 4; ++q) { int row = row0 + q * NGW; row = row < MP ? row : row0;
            pq[q] = lane < 32 ? *(const GAS float*)(ssq + (size_t)row * 32 + lane) : 0.f;
#pragma unroll
            for (int j = 0; j < 2; ++j) v[q][j] = *(const GAS u32x4*)(AB + (size_t)row * 2048 + 8 * lane + 512 * j); }
#pragma unroll
        for (int q = 0; q < 4; ++q) { const int row = row0 + q * NGW;
            if (row < MP) { const float rs = __builtin_amdgcn_rsqf(wave_sum(pq[q]) * (1.0f / 1024.f) + EPS);
#pragma unroll
                for (int j = 0; j < 2; ++j) { u32x4 w = v[q][j];
                    w.x = pk2(bflo(w.x) * rs, bfhi(w.x) * rs); w.y = pk2(bflo(w.y) * rs, bfhi(w.y) * rs); w.z = pk2(bflo(w.z) * rs, bfhi(w.z) * rs); w.w = pk2(bflo(w.w) * rs, bfhi(w.w) * rs);
                    if (!dry || w.x == 0x12345678u) *(GAS u32x4*)(AB + (size_t)row * 2048 + 8 * lane + 512 * j) = w; } }
        }
    }
}
__device__ __forceinline__ void rgconv_phase(PTAB ptab, int wv_, int o) {
    conv_pass<false>(wv_, (const bf16_t*)(WSP + WS_R + R_X), 1280, INP(22) + (size_t)o * 4 * 1280, INP(23) + (size_t)o * 1280, (bf16_t*)(WSP + WS_R + R_XR));
}
constexpr int SC_NC = 33;
__device__ __forceinline__ void scan_a_phase(PTAB ptab, int wv_) {
    const GAS bf16_t* LA = (const GAS bf16_t*)(WSP + WS_R + R_X); const GAS bf16_t* U = (const GAS bf16_t*)(OUTB + DO_Q);
    GAS float* SL = (GAS float*)(WSP + WS_SL); GAS float* SB = (GAS float*)(WSP + WS_SB);
    for (int it = blockIdx.x * NTHR + tid_opaque(); it < NB * SC_NC * 320; it += gridDim.x * NTHR) {
        const int c4 = (it % 320) * 4, bc = it / 320, ck = bc % SC_NC, b = bc / SC_NC;
        const int t0 = ck * 128, n = (T_ - t0) < 128 ? (T_ - t0) : 128;
        const size_t base = ((size_t)b * T_ + t0) * 1280 + c4;
        float h[4] = {0.f, 0.f, 0.f, 0.f}, sl[4] = {0.f, 0.f, 0.f, 0.f};
        for (int l0 = 0; l0 < n; l0 += 8) {
            u32x2 av[8], uv[8];
#pragma unroll
            for (int k = 0; k < 8; ++k) { av[k] = *(const GAS u32x2*)(LA + base + (size_t)(l0 + k) * 1280); uv[k] = *(const GAS u32x2*)(U + base + (size_t)(l0 + k) * 1280); }
#pragma unroll
            for (int k = 0; k < 8; ++k) { const float l0f = bflo(av[k].x), l1 = bfhi(av[k].x), l2 = bflo(av[k].y), l3 = bfhi(av[k].y);
                h[0] = __expf(l0f) * h[0] + bflo(uv[k].x); h[1] = __expf(l1) * h[1] + bfhi(uv[k].x); h[2] = __expf(l2) * h[2] + bflo(uv[k].y); h[3] = __expf(l3) * h[3] + bfhi(uv[k].y);
                sl[0] += l0f; sl[1] += l1; sl[2] += l2; sl[3] += l3; }
        }
        *(GAS f32x4*)(SL + (size_t)bc * 1280 + c4) = (f32x4){sl[0], sl[1], sl[2], sl[3]};
        *(GAS f32x4*)(SB + (size_t)bc * 1280 + c4) = (f32x4){h[0], h[1], h[2], h[3]};
    }
}
__device__ __forceinline__ void scan_c_phase(PTAB ptab, int wv_, bool dry = false) {
    const GAS bf16_t* LA = (const GAS bf16_t*)(WSP + WS_R + R_X); GAS bf16_t* U = (GAS bf16_t*)(OUTB + DO_Q); const GAS bf16_t* G = (const GAS bf16_t*)(WSP + WS_R + R_G);
    const GAS float* SL = (const GAS float*)(WSP + WS_SL); const GAS float* SB = (const GAS float*)(WSP + WS_SB);
    for (int it = blockIdx.x * NTHR + tid_opaque(); it < NB * SC_NC * 320; it += gridDim.x * NTHR) {
        const int c4 = (it % 320) * 4, bc = it / 320, ck = bc % SC_NC, b = bc / SC_NC;
        const int t0 = ck * 128, n = (T_ - t0) < 128 ? (T_ - t0) : 128;
        const size_t base = ((size_t)b * T_ + t0) * 1280 + c4;
        float h[4] = {0.f, 0.f, 0.f, 0.f};
        for (int j0 = 0; j0 < ck; j0 += 4) {
            f32x4 sl[4], sb[4];
#pragma unroll
            for (int k = 0; k < 4; ++k) { const int j = (j0 + k) < ck ? (j0 + k) : (ck - 1); sl[k] = *(const GAS f32x4*)(SL + (size_t)(b * SC_NC + j) * 1280 + c4); sb[k] = *(const GAS f32x4*)(SB + (size_t)(b * SC_NC + j) * 1280 + c4); }
#pragma unroll
            for (int k = 0; k < 4; ++k) if (j0 + k < ck) { h[0] = __expf(sl[k][0]) * h[0] + sb[k][0]; h[1] = __expf(sl[k][1]) * h[1] + sb[k][1]; h[2] = __expf(sl[k][2]) * h[2] + sb[k][2]; h[3] = __expf(sl[k][3]) * h[3] + sb[k][3]; }
        }
        for (int l0 = 0; l0 < n; l0 += 8) {
            u32x2 av[8], uv[8], gv[8];
#pragma unroll
            for (int k = 0; k < 8; ++k) { const size_t o = base + (size_t)(l0 + k) * 1280; av[k] = *(const GAS u32x2*)(LA + o); uv[k] = *(const GAS u32x2*)(U + o); gv[k] = *(const GAS u32x2*)(G + o); }
#pragma unroll
            for (int k = 0; k < 8; ++k) {
                h[0] = __expf(bflo(av[k].x)) * h[0] + bflo(uv[k].x); h[1] = __expf(bfhi(av[k].x)) * h[1] + bfhi(uv[k].x); h[2] = __expf(bflo(av[k].y)) * h[2] + bflo(uv[k].y); h[3] = __expf(bfhi(av[k].y)) * h[3] + bfhi(uv[k].y);
                u32x2 w; w.x = pk2(h[0] * bflo(gv[k].x), h[1] * bfhi(gv[k].x)); w.y = pk2(h[2] * bflo(gv[k].y), h[3] * bfhi(gv[k].y));
                if (!dry || w.x == 0x12345678u) *(GAS u32x2*)(U + base + (size_t)(l0 + k) * 1280) = w; }
        }
    }
}

typedef short v4i16_t __attribute__((ext_vector_type(4)));
__device__ __forceinline__ s16x4 vtr(const LAS unsigned char* p) { return __builtin_bit_cast(s16x4, __builtin_amdgcn_ds_read_tr16_b64_v4i16((LAS v4i16_t*)p)); }
#define MFMA32(a, b, c) __builtin_amdgcn_mfma_f32_32x32x16_bf16((a), (b), (c), 0, 0, 0)
constexpr int SD_BP = 272, SD_XP = 192;
constexpr int SD_B = 0, SD_C = 128 * SD_BP, SD_X = 2 * 128 * SD_BP, SD_XS = SD_X + 128 * SD_XP, SD_S = SD_XS + 128 * SD_XP, SD_ACS = SD_S + 64 * SD_BP, SD_DT = SD_ACS + 512, SD_F = SD_DT + 512, SD_END = SD_F + 512;
static_assert(SD_END <= LDS_CTL, "SSD LDS map");
__device__ __forceinline__ void ssd_phase(PTAB ptab, int wv_, int e, LAS unsigned char* lds, bool dry = false) {
    const int tid = tid_opaque(), lane = tid & 63, wid = __builtin_amdgcn_readfirstlane(tid >> 6), r = lane & 31, hh = lane >> 5;
    const int lb = wid & 3, pb = wid >> 2, q4 = (lane & 15) >> 2, p4 = lane & 3, blk = (lane >> 4) & 1;
    const bf16_t* XC = (const bf16_t*)(OUTB + DO_Q); const float* DT = (const float*)(WSP + WS_DT);
    bf16_t* AB = (bf16_t*)(WSP + WS_R + R_AB); float* ssq = (float*)(WSP + WS_SSQS);
    LAS float* acs = (LAS float*)(lds + SD_ACS); LAS float* dts = (LAS float*)(lds + SD_DT); LAS float* fs = (LAS float*)(lds + SD_F);
    for (int u2 = blockIdx.x; u2 < NB * 32; u2 += gridDim.x) {
        const int u = u2 >> 1, half = u2 & 1;
        const int b = u >> 4, h = u & 15, g = h >> 3;
        const float ah = -__expf(INP(12)[e * 16 + h]), Dh = INP(13)[e * 16 + h];
        const size_t rowbase = (size_t)b * T_;
        f32x16 st;
#pragma unroll
        for (int i = 0; i < 16; ++i) st[i] = 0.f;
        __syncthreads();
        for (int i = tid; i < 64 * SD_BP / 4; i += NTHR) ((LAS unsigned*)(lds + SD_S))[i] = 0u;
        for (int ck = 0; ck < (half ? 33 : 17); ++ck) {
            const bool light = half && ck < 17;
            const int t0 = ck * 128, nv = (T_ - t0) < 128 ? (T_ - t0) : 128;
            u32x4 gb[4], gc[4], gx[2];
#pragma unroll
            for (int k = 0; k < 4; ++k) { const int c = tid + 512 * k, row = c >> 4, cc = c & 15; gb[k] = (u32x4){0u, 0u, 0u, 0u}; gc[k] = gb[k];
                if (row < nv) { const bf16_t* src = XC + (rowbase + t0 + row) * 1536 + 1024 + g * 128 + cc * 8; gb[k] = *(const u32x4*)src; if (!light) gc[k] = *(const u32x4*)(src + 256); } }
#pragma unroll
            for (int k = 0; k < 2; ++k) { const int c = tid + 512 * k, row = c >> 3, cc = c & 7; gx[k] = (u32x4){0u, 0u, 0u, 0u};
                if (row < nv) gx[k] = *(const u32x4*)(XC + (rowbase + t0 + row) * 1536 + h * 64 + cc * 8); }
            float dtv = 0.f; if (tid < nv) dtv = DT[(rowbase + t0 + tid) * 16 + h];
            __syncthreads();
#pragma unroll
            for (int k = 0; k < 4; ++k) { const int c = tid + 512 * k, row = c >> 4, cc = c & 15;
                *(LAS u32x4*)(lds + SD_B + row * SD_BP + cc * 16) = gb[k]; if (!light) *(LAS u32x4*)(lds + SD_C + row * SD_BP + cc * 16) = gc[k]; }
#pragma unroll
            for (int k = 0; k < 2; ++k) { const int c = tid + 512 * k, row = c >> 3, cc = c & 7; *(LAS u32x4*)(lds + SD_X + row * SD_XP + cc * 16) = gx[k]; }
            if (tid < 128) dts[tid] = dtv;
            __syncthreads();
            if (wid == 0) {
                const float d0 = dts[2 * lane], d1 = dts[2 * lane + 1], v0 = d0 * ah, v1 = d1 * ah; float sc = v0 + v1;
#pragma unroll
                for (int o = 1; o < 64; o <<= 1) { const float t = __shfl_up(sc, o); if (lane >= o) sc += t; }
                const float a1 = sc, a0 = sc - v1, ae = __shfl(sc, 63);
                acs[2 * lane + 1] = a1; acs[2 * lane] = a0;
                fs[2 * lane] = d0 * __expf(ae - a0); fs[2 * lane + 1] = d1 * __expf(ae - a1);
            }
            __syncthreads();
            const float aend = acs[127];
#pragma unroll
            for (int k = 0; k < 2; ++k) { const int c = tid + 512 * k, row = c >> 3, cc = c & 7; const float f = fs[row]; const u32x4 xv = gx[k]; u32x4 o;
                o.x = pk2(bflo(xv.x) * f, bfhi(xv.x) * f); o.y = pk2(bflo(xv.y) * f, bfhi(xv.y) * f); o.z = pk2(bflo(xv.z) * f, bfhi(xv.z) * f); o.w = pk2(bflo(xv.w) * f, bfhi(xv.w) * f);
                *(LAS u32x4*)(lds + SD_XS + row * SD_XP + cc * 16) = o; }
            __syncthreads();
            f32x16 y;
            if (!light) {
            bf16x8 cf[8];
#pragma unroll
            for (int ks = 0; ks < 8; ++ks) cf[ks] = *(const LAS bf16x8*)(lds + SD_C + (32 * lb + r) * SD_BP + (16 * ks + 8 * hh) * 2);
#pragma unroll
            for (int i = 0; i < 16; ++i) y[i] = 0.f;
#pragma unroll
            for (int ks = 0; ks < 8; ++ks) { const bf16x8 sf = *(const LAS bf16x8*)(lds + SD_S + (32 * pb + r) * SD_BP + (16 * ks + 8 * hh) * 2); y = MFMA32(sf, cf[ks], y); }
            const float al = acs[32 * lb + r], eal = __expf(al);
#pragma unroll
            for (int i = 0; i < 16; ++i) y[i] *= eal;
            for (int sb = 0; sb <= lb; ++sb) {
                f32x16 cb;
#pragma unroll
                for (int i = 0; i < 16; ++i) cb[i] = 0.f;
#pragma unroll
                for (int ks = 0; ks < 8; ++ks) { const bf16x8 bfr = *(const LAS bf16x8*)(lds + SD_B + (32 * sb + r) * SD_BP + (16 * ks + 8 * hh) * 2); cb = MFMA32(bfr, cf[ks], cb); }
#pragma unroll
                for (int i = 0; i < 16; ++i) { const int sl = (i & 3) + 8 * (i >> 2) + 4 * hh, s = 32 * sb + sl;
                    const float w = __expf(al - acs[s]) * dts[s]; const bool keep = (sb < lb) || (sl <= r); cb[i] = keep ? cb[i] * w : 0.f; }
#pragma unroll
                for (int s2 = 0; s2 < 2; ++s2) {
                    u32x4 pw; pw.x = pk2(cb[8 * s2], cb[8 * s2 + 1]); pw.y = pk2(cb[8 * s2 + 2], cb[8 * s2 + 3]); pw.z = pk2(cb[8 * s2 + 4], cb[8 * s2 + 5]); pw.w = pk2(cb[8 * s2 + 6], cb[8 * s2 + 7]);
                    const LAS unsigned char* xa = lds + SD_X + (32 * sb + 16 * s2 + 4 * hh + q4) * SD_XP + pb * 64 + 32 * blk + 8 * p4;
                    const s16x4 lo = vtr(xa), hi = vtr(xa + 8 * SD_XP);
                    const bf16x8 xf = {lo[0], lo[1], lo[2], lo[3], hi[0], hi[1], hi[2], hi[3]};
                    y = MFMA32(xf, __builtin_bit_cast(bf16x8, pw), y);
                }
            }
            }
            { const float cd = __expf(aend);
#pragma unroll
              for (int i = 0; i < 16; ++i) st[i] *= cd;
#pragma unroll
              for (int ks = 0; ks < 8; ++ks) {
                  const LAS unsigned char* ba = lds + SD_B + (16 * ks + 8 * hh + q4) * SD_BP + lb * 64 + 32 * blk + 8 * p4;
                  const s16x4 blo = vtr(ba), bhi = vtr(ba + 4 * SD_BP);
                  const bf16x8 bt = {blo[0], blo[1], blo[2], blo[3], bhi[0], bhi[1], bhi[2], bhi[3]};
                  const LAS unsigned char* xa = lds + SD_XS + (16 * ks + 8 * hh + q4) * SD_XP + pb * 64 + 32 * blk + 8 * p4;
                  const s16x4 xlo = vtr(xa), xhi = vtr(xa + 4 * SD_XP);
                  const bf16x8 xs = {xlo[0], xlo[1], xlo[2], xlo[3], xhi[0], xhi[1], xhi[2], xhi[3]};
                  st = MFMA32(bt, xs, st);
              } }
            if (!light) { const int l = 32 * lb + r; float q = 0.f;
              if (l < nv) {
#pragma unroll
                  for (int gq = 0; gq < 4; ++gq) { const int p0 = 32 * pb + 8 * gq + 4 * hh;
                      const u32x2 xv = *(const LAS u32x2*)(lds + SD_X + l * SD_XP + p0 * 2);
                      u32x2* zp = (u32x2*)(AB + (rowbase + t0 + l) * 2048 + h * 64 + p0); const u32x2 zv = *zp;
                      const float o0 = (y[4 * gq] + Dh * bflo(xv.x)) * siluf_(bflo(zv.x)), o1 = (y[4 * gq + 1] + Dh * bfhi(xv.x)) * siluf_(bfhi(zv.x));
                      const float o2 = (y[4 * gq + 2] + Dh * bflo(xv.y)) * siluf_(bflo(zv.y)), o3 = (y[4 * gq + 3] + Dh * bfhi(xv.y)) * siluf_(bfhi(zv.y));
                      u32x2 w; w.x = pk2(o0, o1); w.y = pk2(o2, o3); if (!dry) *zp = w;
                      q += (o0 * o0 + o1 * o1) + (o2 * o2 + o3 * o3); }
              }
              q += __shfl_xor(q, 32);
              if (hh == 0 && l < nv && !dry) ssq[(rowbase + t0 + l) * 32 + h * 2 + pb] = q; }
            __syncthreads();
#pragma unroll
            for (int gq = 0; gq < 4; ++gq) { u32x2 w; w.x = pk2(st[4 * gq], st[4 * gq + 1]); w.y = pk2(st[4 * gq + 2], st[4 * gq + 3]);
                *(LAS u32x2*)(lds + SD_S + (32 * pb + r) * SD_BP + (32 * lb + 8 * gq + 4 * hh) * 2) = w; }
        }
    }
}

constexpr int AT_KP = 208, AT_VP = 192, AT_KB = 64 * AT_KP, AT_VB = 64 * AT_VP;
constexpr int AT_NQB = 17, AT_NU = NB * 16 * AT_NQB;
__device__ __forceinline__ void attn_phase(PTAB ptab, int wv_, LAS unsigned char* lds, unsigned* counter) {
    const int tid = tid_opaque(), lane = tid & 63, wid = __builtin_amdgcn_readfirstlane(tid >> 6), r = lane & 31, hh = lane >> 5;
    const bf16_t* Q = (const bf16_t*)(OUTB + DO_Q); const bf16_t* KV = (const bf16_t*)(WSP + WS_R + R_KV); const bf16_t* KR = (const bf16_t*)(WSP + WS_KR);
    bf16_t* AB = (bf16_t*)(WSP + WS_R + R_AB);
    LAS unsigned* slot = (LAS unsigned*)(lds + 2 * AT_KB + 2 * AT_VB);
    const unsigned xcc0 = xcc_id_() & 7u;
    if (wid < 4) __builtin_amdgcn_s_setprio(2);
    const int c0r = tid >> 4, c0c = tid & 15, c1r = c0r + 32, rkr = (tid & 255) >> 2, rkc = tid & 3;
    const int d0off = c0c < 8 ? c0r * AT_KP + c0c * 16 : 2 * AT_KB + c0r * AT_VP + (c0c - 8) * 16;
    const int d1off = c0c < 8 ? c1r * AT_KP + c0c * 16 : 2 * AT_KB + c1r * AT_VP + (c0c - 8) * 16;
    const int dboff = c0c < 8 ? AT_KB : AT_VB, drope = rkr * AT_KP + 128 + rkc * 16;
    const int q4 = (lane & 15) >> 2, p4 = lane & 3, blk = (lane >> 4) & 1;
    for (int xo = 0; xo < 1; ++xo) {
    const unsigned xcc = 0u; (void)xcc0;
    for (;;) {
        __syncthreads();
        if (tid == 0) *slot = atomicAdd(counter + 16 * xcc, 1u);
        __syncthreads();
        const unsigned ui = *slot;
        if (ui >= (unsigned)AT_NU) break;
        const int qb = 16 - (int)(ui >> 7), bh = (int)(ui & 127u), b = bh >> 4, h = bh & 15;
        const int q0 = qb == 0 ? 0 : 16 + 256 * (qb - 1); const size_t rowbase = (size_t)b * T_;
        const int qend = qb == 0 ? 16 : q0 + 256, nt = (qend + 63) >> 6;
        const int qrow = q0 + 32 * wid + r, qrc = qrow < T_ ? qrow : (T_ - 1);
        const int qwmin = q0 + 32 * wid, qwmax = qwmin + 31;
        bf16x8 qf[6];
        { const bf16_t* qp = Q + (rowbase + qrc) * 1536 + h * 96 + 8 * hh;
#pragma unroll
          for (int ks = 0; ks < 6; ++ks) qf[ks] = *(const GAS bf16x8*)(qp + 16 * ks); }
        float m_run = 0.f, l_run = 0.f; f32x16 o[2];
#pragma unroll
        for (int i = 0; i < 16; ++i) { o[0][i] = 0.f; o[1][i] = 0.f; }
        u32x4 gk0[2], gk1[2], gv[2];
#define AT_BAR() asm volatile("s_waitcnt lgkmcnt(0)\n\ts_barrier" ::: "memory")
#define AT_LOAD(t, S) do { const int kb_ = (t) * 64; \
        { int rr = kb_ + c0r; rr = rr < T_ ? rr : T_ - 1; gk0[S] = *(const GAS u32x4*)(KV + (rowbase + rr) * 2048 + h * 128 + c0c * 8); } \
        { int rr = kb_ + c1r; rr = rr < T_ ? rr : T_ - 1; gk1[S] = *(const GAS u32x4*)(KV + (rowbase + rr) * 2048 + h * 128 + c0c * 8); } \
        { int rr = kb_ + rkr; rr = rr < T_ ? rr : T_ - 1; gv[S] = *(const GAS u32x4*)(KR + (rowbase + rr) * 32 + rkc * 8); } } while (0)
#define AT_STORE(buf, S) do { *(LAS u32x4*)(lds + d0off + (buf) * dboff) = gk0[S]; *(LAS u32x4*)(lds + d1off + (buf) * dboff) = gk1[S]; \
        *(LAS u32x4*)(lds + (buf) * AT_KB + drope) = gv[S]; } while (0)
        AT_LOAD(0, 0); AT_STORE(0, 0);
        if (nt > 1) AT_LOAD(1, 1);
        if (nt > 2) AT_LOAD(2, 0);
        AT_BAR();
        for (int t2 = 0; t2 < nt; t2 += 2) {
#pragma unroll
          for (int hf = 0; hf < 2; ++hf) {
            const int t = t2 + hf, cur = hf;
            if (t < nt) {
            if (t * 64 <= qwmax && qwmin < qend) {
                const LAS unsigned char* kb = lds + cur * AT_KB; const LAS unsigned char* vb = lds + 2 * AT_KB + cur * AT_VB;
                f32x16 p0, p1;
#pragma unroll
                for (int i = 0; i < 16; ++i) { p0[i] = -m_run; p1[i] = -m_run; }
                bf16x8 kf[12], vf[8];
#pragma unroll
                for (int ks = 0; ks < 6; ++ks) { kf[2 * ks] = *(const LAS bf16x8*)(kb + r * AT_KP + (16 * ks + 8 * hh) * 2); kf[2 * ks + 1] = *(const LAS bf16x8*)(kb + (32 + r) * AT_KP + (16 * ks + 8 * hh) * 2); }
#pragma unroll
                for (int i8 = 0; i8 < 8; ++i8) { const int kbk = i8 >> 2, s = (i8 >> 1) & 1, dv = i8 & 1;
                    const LAS unsigned char* va = vb + (32 * kbk + 16 * s + 4 * hh + q4) * AT_VP + dv * 64 + 32 * blk + 8 * p4;
                    const s16x4 lo = vtr(va), hi = vtr(va + 8 * AT_VP);
                    vf[i8] = (bf16x8){lo[0], lo[1], lo[2], lo[3], hi[0], hi[1], hi[2], hi[3]}; }
                __builtin_amdgcn_sched_barrier(0);
#pragma unroll
                for (int ks = 0; ks < 6; ++ks) { p0 = MFMA32(kf[2 * ks], qf[ks], p0); p1 = MFMA32(kf[2 * ks + 1], qf[ks], p1); }
                __builtin_amdgcn_sched_barrier(0);
                if (t * 64 + 63 > qwmin) {
#pragma unroll
                    for (int i = 0; i < 16; ++i) { const int kv = t * 64 + (i & 3) + 8 * (i >> 2) + 4 * hh;
                        if (kv > qrow) p0[i] = -INFINITY; if (kv + 32 > qrow) p1[i] = -INFINITY; }
                }
                float mxa = fmaxf(p0[0], p1[0]), mxb = fmaxf(p0[1], p1[1]);
#pragma unroll
                for (int i = 2; i < 16; i += 2) { mxa = fmaxf(fmaxf(mxa, p0[i]), p1[i]); mxb = fmaxf(fmaxf(mxb, p0[i + 1]), p1[i + 1]); }
                float mx = fmaxf(mxa, mxb);
                { const auto sw_ = __builtin_amdgcn_permlane32_swap(__float_as_uint(mx), __float_as_uint(mx), false, false); mx = fmaxf(__uint_as_float(sw_[0]), __uint_as_float(sw_[1])); }
                if (t == 0 || __builtin_amdgcn_ballot_w64(mx > 8.0f) != 0ull) {
                    const float d = (t == 0) ? mx : fmaxf(mx, 0.f), alpha = __builtin_amdgcn_exp2f(-d);
                    m_run += d; l_run *= alpha;
#pragma unroll
                    for (int i = 0; i < 16; ++i) { p0[i] -= d; p1[i] -= d; o[0][i] *= alpha; o[1][i] *= alpha; }
                }
                float rsa = 0.f, rsb = 0.f;
#pragma unroll
                for (int i = 0; i < 16; ++i) { p0[i] = __builtin_amdgcn_exp2f(p0[i]); p1[i] = __builtin_amdgcn_exp2f(p1[i]);
                    asm("v_add_f32_e32 %0, %1, %2" : "=v"(rsa) : "v"(rsa), "v"(p0[i])); asm("v_add_f32_e32 %0, %1, %2" : "=v"(rsb) : "v"(rsb), "v"(p1[i])); }
                const float rs = rsa + rsb;
                l_run += rs;
#pragma unroll
                for (int kbk = 0; kbk < 2; ++kbk)
#pragma unroll
                    for (int s = 0; s < 2; ++s) {
                        u32x4 pw;
                        if (kbk == 0) { pw.x = pk2(p0[8 * s], p0[8 * s + 1]); pw.y = pk2(p0[8 * s + 2], p0[8 * s + 3]); pw.z = pk2(p0[8 * s + 4], p0[8 * s + 5]); pw.w = pk2(p0[8 * s + 6], p0[8 * s + 7]); }
                        else { pw.x = pk2(p1[8 * s], p1[8 * s + 1]); pw.y = pk2(p1[8 * s + 2], p1[8 * s + 3]); pw.z = pk2(p1[8 * s + 4], p1[8 * s + 5]); pw.w = pk2(p1[8 * s + 6], p1[8 * s + 7]); }
                        const bf16x8 pf = __builtin_bit_cast(bf16x8, pw);
#pragma unroll
                        for (int dv = 0; dv < 2; ++dv) o[dv] = MFMA32(vf[kbk * 4 + s * 2 + dv], pf, o[dv]);
                    }
            }
            if (t + 1 < nt) AT_STORE(cur ^ 1, hf ^ 1);
            if (t + 3 < nt) AT_LOAD(t + 3, hf ^ 1);
            AT_BAR();
            }
          }
        }
        if (qrow < qend) {
            const float il = 1.0f / (l_run + __shfl_xor(l_run, 32));
            bf16_t* op = AB + (rowbase + qrow) * 2048 + 1024 + h * 64;
#pragma unroll
            for (int dv = 0; dv < 2; ++dv)
#pragma unroll
                for (int gq = 0; gq < 4; ++gq) { u32x2 w; w.x = pk2(o[dv][4 * gq] * il, o[dv][4 * gq + 1] * il); w.y = pk2(o[dv][4 * gq + 2] * il, o[dv][4 * gq + 3] * il);
                    *(u32x2*)(op + dv * 32 + 8 * gq + 4 * hh) = w; }
        }
    }
    }
    __builtin_amdgcn_s_setprio(0);
#undef AT_LOAD
#undef AT_BAR
#undef AT_STORE
}

#define XB_TMO      128
#define XB_XCNT(j)  (256  + 64 * (j))
#define XB_XSUB(j)  (1280 + 64 * (j))
#define XB_XGEN(j)  (2304 + 64 * (j))
#define XB_TOP      3328
#define XB_TOPGEN   3392
#define XCD_BAR_WORDS 3456
#define XB_SPIN_CAP (1u << 18)

__device__ __forceinline__ unsigned xb_ld(unsigned* p)              { return __hip_atomic_load(p, __ATOMIC_RELAXED, __HIP_MEMORY_SCOPE_AGENT); }
__device__ __forceinline__ unsigned xb_add(unsigned* p, unsigned v) { return __hip_atomic_fetch_add(p, v, __ATOMIC_RELAXED, __HIP_MEMORY_SCOPE_AGENT); }
__device__ __forceinline__ unsigned xb_xcc_id() { return (unsigned)__builtin_amdgcn_s_getreg((3 << 11) | 20) & 0xFu; }
#define XB_SPIN(cond, bar) do { unsigned _sp = 0; while (cond) { __builtin_amdgcn_s_sleep(1); \
    if ((++_sp & 255u) == 0u) { if (xb_ld(&(bar)[XB_TMO])) break; if (_sp > XB_SPIN_CAP) { atomicAdd(&(bar)[XB_TMO], 1u); break; } } } } while (0)

struct XcdBarrier {
    unsigned* bar; unsigned x;
    volatile LAS unsigned* st;
};

__device__ __forceinline__ XcdBarrier xcd_barrier_post(unsigned* bar, volatile LAS unsigned* st, int wv_) {
    XcdBarrier b; b.bar = bar; b.x = xb_xcc_id(); b.st = st;
    if (tid_opaque() == 0) (void)xb_add(&bar[XB_XCNT(b.x)], 1u);
    return b;
}
__device__ __forceinline__ void xcd_barrier_complete(unsigned* bar, unsigned x, unsigned& nloc, unsigned& nx) {
    const unsigned G = gridDim.x * gridDim.y * gridDim.z;
    unsigned sum, cnt, mine, sp = 0u;
    for (;;) {
        sum = 0u; cnt = 0u; mine = 0u;
#pragma unroll
        for (unsigned j = 0; j < 16; ++j) { const unsigned c = xb_ld(&bar[XB_XCNT(j)]); sum += c; cnt += (c > 0u) ? 1u : 0u; mine = (j == x) ? c : mine; }
        if (sum == G) break;
        __builtin_amdgcn_s_sleep(1);
        if ((++sp & 255u) == 0u) { if (xb_ld(&bar[XB_TMO])) break; if (sp > XB_SPIN_CAP) { atomicAdd(&bar[XB_TMO], 1u); break; } }
    }
    nloc = mine > 0u ? mine : 1u; nx = cnt > 0u ? cnt : 1u;
}

__device__ __forceinline__ void xcd_barrier(const XcdBarrier& b, int wv_) {
    asm volatile("s_waitcnt vmcnt(0)" ::: "memory");
    __syncthreads();
    if (tid_opaque() == 0) {
        unsigned* bar = b.bar;
        __builtin_amdgcn_s_waitcnt(0);
        unsigned nloc = b.st[0], nx = b.st[1];
        if (nloc == 0u) { xcd_barrier_complete(bar, b.x, nloc, nx); b.st[0] = nloc; b.st[1] = nx; }
        const unsigned old = xb_add(&bar[XB_XSUB(b.x)], 1u);
        const unsigned gen = old / nloc;
        if (old + 1u == (gen + 1u) * nloc) {
            __builtin_amdgcn_fence(__ATOMIC_RELEASE, "agent");
            asm volatile("s_waitcnt vmcnt(0)" ::: "memory");
            const unsigned og = xb_add(&bar[XB_TOP], 1u);
            const unsigned tg = og / nx;
            if (og + 1u == (tg + 1u) * nx) xb_add(&bar[XB_TOPGEN], 1u);
            else XB_SPIN(xb_ld(&bar[XB_TOPGEN]) == tg, bar);
            __builtin_amdgcn_fence(__ATOMIC_ACQUIRE, "agent");
            xb_add(&bar[XB_XGEN(b.x)], 1u);
            asm volatile("s_waitcnt vmcnt(0)" ::: "memory");
        } else {
            XB_SPIN(xb_ld(&bar[XB_XGEN(b.x)]) == gen, bar);
            __builtin_amdgcn_fence(__ATOMIC_ACQUIRE, "agent");
            asm volatile("s_waitcnt vmcnt(0)" ::: "memory");
        }
    }
    __syncthreads();
}

__global__ void __launch_bounds__(NTHR) hybrid_fwd(Params P) {
    extern __shared__ __attribute__((aligned(16))) unsigned char lds_raw[];
    LAS unsigned char* lds = (LAS unsigned char*)lds_raw;
    cg::grid_group grid = cg::this_grid();
    const int wv_ = __builtin_amdgcn_readfirstlane(threadIdx.x >> 6);
    PTAB ptab = (PTAB)__builtin_amdgcn_kernarg_segment_ptr();
#if PROBE & 1
#define GBAR() do { GBAR1(); GBAR1(); } while (0)
#else
#define GBAR() GBAR1()
#endif
#define GBAR1() do { unsigned sta_ = (unsigned)LDS_CTL + 64u; asm volatile("" : "+v"(sta_)); XcdBarrier xb_; xb_.bar = (unsigned*)(WSP + WS_CTL) + 1024; xb_.x = xb_xcc_id(); \
    xb_.st = (volatile LAS unsigned*)(lds + sta_); xcd_barrier(xb_, wv_); } while (0)
#define ws WSP
#define dob OUTB
#define rstd_h ((float*)(WSP + WS_RSTDH))
#define ssqm ((float*)(WSP + WS_SSQM))
#define HB ((bf16_t*)(WSP + WS_HB))
#define WOFF(o) ((bf16_t*)(WSP + WS_W + (o)))
    { volatile LAS unsigned* st0 = (volatile LAS unsigned*)(lds + LDS_CTL + 64); if (tid_opaque() == 0) { st0[0] = 0u; st0[1] = 0u; } __syncthreads(); }
    (void)xcd_barrier_post((unsigned*)(WSP + WS_CTL) + 1024, (volatile LAS unsigned*)(lds + LDS_CTL + 64), wv_);
    unsigned my_rank_ = 0, my_xcc_ = xb_xcc_id();
    if (tid_opaque() == 0) my_rank_ = __hip_atomic_fetch_add((unsigned*)(WSP + WS_CTL) + 512 + 16 * my_xcc_, 1u, __ATOMIC_RELAXED, __HIP_MEMORY_SCOPE_AGENT);
    grid.sync();
    { volatile LAS unsigned* vc = (volatile LAS unsigned*)(lds + LDS_CTL + 128);
      if (tid_opaque() == 0) { bool ok = (gridDim.x & 7u) == 0u;
          for (int j = 0; j < 8; ++j) ok = ok && (__hip_atomic_load((unsigned*)(WSP + WS_CTL) + 512 + 16 * j, __ATOMIC_RELAXED, __HIP_MEMORY_SCOPE_AGENT) == gridDim.x / 8u);
          vc[0] = ok ? (my_rank_ * 8u + my_xcc_) : blockIdx.x; }
      __syncthreads(); }
#if PROBE & 128
    convert_layer(ptab, wv_, 0, lds);
    setup_rows(ptab, wv_);
#endif
    convert_layer(ptab, wv_, 0, lds);
    setup_rows(ptab, wv_);
    GBAR();
#pragma unroll 1
    for (int L = 0; L < 4; ++L) {
        if ((L & 1) == 0) {
            const int e = L >> 1;
            bf16_t* AB = (bf16_t*)(ws + WS_R + R_AB); bf16_t* LAT = (bf16_t*)(ws + WS_R + R_LAT); bf16_t* XKV = (bf16_t*)(ws + WS_R + R_KV); bf16_t* Qb = (bf16_t*)(dob + DO_Q);
#if PROBE & 256
            { Epi<EP_IN> E{rstd_h, AB, XKV, LAT, nullptr, nullptr, nullptr, nullptr, nullptr};
              run_gemm<EP_IN>(wv_, lds, HB, 1024, 0, WOFF(W_IN), 3328, 1024, E); }
            GBAR();
#endif
            { Epi<EP_IN> E{rstd_h, AB, XKV, LAT, nullptr, nullptr, nullptr, nullptr, nullptr};
              run_gemm<EP_IN>(wv_, lds, HB, 1024, 0, WOFF(W_IN), 3328, 1024, E); }
            GBAR();
#if PROBE & 64
            prep_phase(ptab, wv_, e); GBAR();
#endif
            prep_phase(ptab, wv_, e);
            GBAR();
#if PROBE & 2
            ssd_phase(ptab, wv_, e, lds, true); GBAR();
#endif
            ssd_phase(ptab, wv_, e, lds);
            GBAR();
#if PROBE & 512
            { Epi<EP_Q> E{(const float*)(ws + WS_RSTDQ), Qb, nullptr, nullptr, nullptr, (const float*)(ws + WS_COS), (const float*)(ws + WS_SIN), nullptr, nullptr};
              run_gemm<EP_Q>(wv_, lds, LAT, 768, 0, WOFF(W_Q), 1536, 384, E); }
            { Epi<EP_KV> E{(const float*)(ws + WS_RSTDKV), XKV, nullptr, nullptr, nullptr, nullptr, nullptr, nullptr, nullptr};
              run_gemm<EP_KV>(wv_, lds, LAT + 384, 768, 0, WOFF(W_KV), 2048, 256, E); }
            GBAR();
#endif
            { Epi<EP_Q> E{(const float*)(ws + WS_RSTDQ), Qb, nullptr, nullptr, nullptr, (const float*)(ws + WS_COS), (const float*)(ws + WS_SIN), nullptr, nullptr};
              run_gemm<EP_Q>(wv_, lds, LAT, 768, 0, WOFF(W_Q), 1536, 384, E); }
            { Epi<EP_KV> E{(const float*)(ws + WS_RSTDKV), XKV, nullptr, nullptr, nullptr, nullptr, nullptr, nullptr, nullptr};
              run_gemm<EP_KV>(wv_, lds, LAT + 384, 768, 0, WOFF(W_KV), 2048, 256, E); }
#if PROBE & 64
            fix_phase(ptab, wv_, true);
#endif
            fix_phase(ptab, wv_);
            GBAR();
#if PROBE & 4
            attn_phase(ptab, wv_, lds, (unsigned*)(ws + WS_CTL) + 6144 + 256 * e); GBAR();
#endif
            attn_phase(ptab, wv_, lds, (unsigned*)(ws + WS_CTL) + 5120 + 256 * e);
            GBAR();
#if PROBE & 4096
            { Epi<EP_M> E{nullptr, (bf16_t*)(ws + WS_M), nullptr, nullptr, ssqm, nullptr, nullptr, nullptr, nullptr};
              run_gemm<EP_M, 1>(wv_, lds, AB, 2048, 0, WOFF(W_O), 1024, 2048, E); }
            GBAR();
#endif
            { Epi<EP_M> E{nullptr, (bf16_t*)(ws + WS_M), nullptr, nullptr, ssqm, nullptr, nullptr, nullptr, nullptr};
              run_gemm<EP_M, 1>(wv_, lds, AB, 2048, 0, WOFF(W_O), 1024, 2048, E); }
        } else {
            const int o = L >> 1;
            bf16_t* X = (bf16_t*)(ws + WS_R + R_X); bf16_t* G = (bf16_t*)(ws + WS_R + R_G); bf16_t* XR = (bf16_t*)(ws + WS_R + R_XR); bf16_t* U = (bf16_t*)(dob + DO_Q);
#if PROBE & 1024
            { Epi<EP_XY> E{rstd_h, X, G, nullptr, nullptr, nullptr, nullptr, nullptr, nullptr};
              run_gemm<EP_XY>(wv_, lds, HB, 1024, 0, WOFF(W_XY), 2560, 1024, E); }
            GBAR();
#endif
            { Epi<EP_XY> E{rstd_h, X, G, nullptr, nullptr, nullptr, nullptr, nullptr, nullptr};
              run_gemm<EP_XY>(wv_, lds, HB, 1024, 0, WOFF(W_XY), 2560, 1024, E); }
            GBAR();
#if PROBE & 64
            rgconv_phase(ptab, wv_, o); GBAR();
#endif
            rgconv_phase(ptab, wv_, o);
            GBAR();
            { Epi<EP_AI> E{nullptr, X, U, nullptr, nullptr, INP(25) + o * 1280, INP(27) + o * 1280, INP(28) + o * 1280, XR};
              run_gemm<EP_AI>(wv_, lds, XR, 1280, 128, WOFF(W_AI), 2560, 128, E); }
            GBAR();
#if PROBE & 32
            scan_a_phase(ptab, wv_); GBAR(); scan_c_phase(ptab, wv_, true); GBAR();
#endif
            scan_a_phase(ptab, wv_);
            GBAR();
            scan_c_phase(ptab, wv_);
            GBAR();
            { Epi<EP_M> E{nullptr, (bf16_t*)(ws + WS_M), nullptr, nullptr, ssqm, nullptr, nullptr, nullptr, nullptr};
              run_gemm<EP_M, 1>(wv_, lds, U, 1280, 0, WOFF(W_RO), 1024, 1280, E); }
        }
        GBAR();
        { Epi<EP_PART> E{nullptr, nullptr, nullptr, nullptr, nullptr, (const float*)(ws + WS_PART), nullptr, nullptr, nullptr};
          if ((L & 1) == 0) run_gemm_tail<EP_PART>(wv_, lds, (bf16_t*)(ws + WS_R + R_AB), 2048, WOFF(W_O), 2048, 1024, 2, E);
          else run_gemm_tail<EP_PART>(wv_, lds, (bf16_t*)(dob + DO_Q), 1280, WOFF(W_RO), 1280, 640, 2, E); }
#if PROBE & 16
        resnorm_phase(ptab, wv_, lds, INP(3) + L * 1024, false, 0, MP - 256, 8, true);
#endif
        resnorm_phase(ptab, wv_, lds, INP(3) + L * 1024, false, 0, MP - 256, 8);
        GBAR();
        tail_reduce_resnorm(ptab, wv_, INP(3) + L * 1024, false, 2);
        GBAR();
#if PROBE & 8
        { Epi<EP_UP> E{rstd_h, (bf16_t*)(ws + WS_R + R_U), nullptr, nullptr, nullptr, nullptr, nullptr, nullptr, nullptr};
          run_gemm<EP_UP>(wv_, lds, HB, 1024, 0, WOFF(W_UP), 4096, 1024, E); }
        GBAR();
#endif
        { Epi<EP_UP> E{rstd_h, (bf16_t*)(ws + WS_R + R_U), nullptr, nullptr, nullptr, nullptr, nullptr, nullptr, nullptr};
          run_gemm<EP_UP>(wv_, lds, HB, 1024, 0, WOFF(W_UP), 4096, 1024, E); }
        GBAR();
#if PROBE & 2048
        { Epi<EP_M> E{nullptr, (bf16_t*)(ws + WS_M), nullptr, nullptr, ssqm, nullptr, nullptr, nullptr, nullptr};
          run_gemm<EP_M, 1>(wv_, lds, (bf16_t*)(ws + WS_R + R_U), 4096, 0, WOFF(W_DN), 1024, 4096, E); }
            GBAR();
#endif
        { Epi<EP_M> E{nullptr, (bf16_t*)(ws + WS_M), nullptr, nullptr, ssqm, nullptr, nullptr, nullptr, nullptr};
          run_gemm<EP_M, 1>(wv_, lds, (bf16_t*)(ws + WS_R + R_U), 4096, 0, WOFF(W_DN), 1024, 4096, E); }
        GBAR();
        { Epi<EP_PART> E{nullptr, nullptr, nullptr, nullptr, nullptr, (const float*)(ws + WS_PART), nullptr, nullptr, nullptr};
          run_gemm_tail<EP_PART>(wv_, lds, (bf16_t*)(ws + WS_R + R_U), 4096, WOFF(W_DN), 4096, 1024, 4, E); }
#if PROBE & 16
        resnorm_phase(ptab, wv_, lds, INP(5) + L * 1024, false, 0, MP - 256, 16, true);
#endif
        resnorm_phase(ptab, wv_, lds, INP(5) + L * 1024, L == 3, 0, MP - 256, 16);
        GBAR();
#if PROBE & 128
        if (L < 3) convert_layer(ptab, wv_, L + 1, lds);
#endif
        if (L < 3) { convert_layer(ptab, wv_, L + 1, lds); tail_reduce_resnorm(ptab, wv_, INP(5) + L * 1024, false, 4); GBAR(); }
        else tail_reduce_resnorm(ptab, wv_, INP(5) + L * 1024, true, 4);
    }
#undef WOFF
#undef ws
#undef dob
#undef rstd_h
#undef ssqm
#undef HB
}

extern "C" void kernel_launch(void* const* d_in, const int* in_sizes, int n_in, void* d_out, int out_size, void* d_ws, size_t ws_size, hipStream_t stream) {
    static int grid_blocks = 0;
    if (grid_blocks == 0) {
        if (n_in != 30 || ws_size < WS_NEED || (size_t)out_size * 4 < DO_Q + (size_t)MP * 1536 * 2) { fprintf(stderr, "kernel_launch: unexpected shapes (n_in %d, ws %zu need %zu, out %d)\n", n_in, ws_size, (size_t)WS_NEED, out_size); grid_blocks = -1; return; }
        int dev = 0, cus = 0, per_cu = 0;
        hipGetDevice(&dev); hipDeviceGetAttribute(&cus, hipDeviceAttributeMultiprocessorCount, dev);
        if (hipFuncSetAttribute((const void*)hybrid_fwd, hipFuncAttributeMaxDynamicSharedMemorySize, LDS_BYTES) != hipSuccess) { fprintf(stderr, "kernel_launch: hipFuncSetAttribute failed\n"); grid_blocks = -1; return; }
        if (hipOccupancyMaxActiveBlocksPerMultiprocessor(&per_cu, (const void*)hybrid_fwd, NTHR, LDS_BYTES) != hipSuccess || per_cu < 1) { fprintf(stderr, "kernel_launch: occupancy query says %d\n", per_cu); per_cu = 1; }
        (void)hipGetLastError();
        grid_blocks = cus * 1;
    }
    if (grid_blocks < 0) return;
    hipMemsetAsync((char*)d_ws + WS_CTL, 0, CTL_BYTES, stream);
    Params p{};
    for (int i = 0; i < 30; ++i) p.in[i] = (const float*)d_in[i];
    p.out = (float*)d_out; p.ws = (unsigned char*)d_ws;
    void* args[] = {&p};
    hipError_t e = hipLaunchCooperativeKernel((const void*)hybrid_fwd, dim3(grid_blocks), dim3(NTHR), args, LDS_BYTES, stream);
    if (e != hipSuccess) fprintf(stderr, "cooperative launch failed: %s (grid %d)\n", hipGetErrorString(e), grid_blocks);
}
```

```cpp
#include <hip/hip_runtime.h>
#include <hip/hip_cooperative_groups.h>
#include <cstdio>
#include <cstdint>
#include <cmath>
namespace cg = cooperative_groups;
#ifndef PROBE
#define PROBE 0
#endif
__device__ __forceinline__ int tid_from(int wv) { int t; asm volatile("v_mbcnt_lo_u32_b32 %0, -1, 0\n\tv_mbcnt_hi_u32_b32 %0, -1, %0\n\tv_lshl_add_u32 %0, %1, 6, %0" : "=&v"(t) : "s"(wv)); return t; }
#define tid_opaque() tid_from(wv_)
namespace pg8 {
#define PG8_LAS __attribute__((address_space(3)))
typedef unsigned short bf16_t;
typedef short bf16x8 __attribute__((ext_vector_type(8)));
typedef float f32x4 __attribute__((ext_vector_type(4)));
typedef unsigned u32x4 __attribute__((ext_vector_type(4)));
constexpr int BM = 256, BK = 64, HALF = 128, HTB = HALF * BK * 2  , STAGE_BYTES = 8 * HTB, NXCD = 8, WGM = 8;

__host__ __device__ __forceinline__ int lds_byte(int r, int c) { const int st = (r >> 4) * 2 + (c >> 5), rr = r & 15, cc = c & 31, ob = rr * 64 + cc * 2; return st * 1024 + (ob ^ (((ob >> 9) & 1) << 5)); }
__host__ __device__ __forceinline__ void stage_rc(int b, int& R, int& C) { const int st = b / 1024, sb = b % 1024, swz = sb ^ (((sb >> 9) & 1) << 5); R = (st >> 1) * 16 + swz / 64; C = (st & 1) * 32 + (swz % 64) / 2; }
__host__ __device__ __forceinline__ int perm32(int rho) { const int n = rho >> 4, i = rho & 15; return 8 * (i >> 2) + 4 * n + (i & 3); }

struct Unit { int pm, pn; };
struct Gemm { const bf16_t* A; const bf16_t* Bt; int M, N, K, lda, ldb, a_pn, half_pm, nsplit_n, kofs; };

struct StaticOrder {
    int nM, nN, nwg, G, c;
    __host__ __device__ void init(int M, int N, int G_, int c_) { nM = M / BM; nN = N / BM; nwg = nM * nN; G = G_; c = c_; }
    __host__ __device__ bool next(int i, Unit& u) const {
        const long L = (long)i * G + c; if (L >= nwg) return false;
        int wgid = (int)L; { const int q = nwg / NXCD, r = nwg % NXCD, xcd = wgid % NXCD, off = wgid / NXCD; wgid = (xcd < r ? xcd * (q + 1) : r * (q + 1) + (xcd - r) * q) + off; }
        const int nig = WGM * nN, gid = wgid / nig, fm = gid * WGM, gsz = (nM - fm) < WGM ? (nM - fm) : WGM;
        u.pm = fm + ((wgid % nig) % gsz); u.pn = (wgid % nig) / gsz; return true;
    }
    __device__ __forceinline__ void a_ready(const Unit&) const {}
    __device__ __forceinline__ void done(const Unit&) const {}
};

__device__ __forceinline__ unsigned cvt_pk_bf16(float lo, float hi) { unsigned r; asm volatile("v_cvt_pk_bf16_f32 %0, %1, %2" : "=v"(r) : "v"(lo), "v"(hi)); return r; }
typedef float f32x2 __attribute__((ext_vector_type(2)));
template <class Epi, class Sched, bool ALIGN_EPI = false, bool SP2 = false>
__device__ __forceinline__ void gemm_phase(int wv_, PG8_LAS unsigned char* lds, const Gemm g, const Sched& S, const Epi& E) {
    const int tid = tid_opaque(), wid = __builtin_amdgcn_readfirstlane(tid >> 6), lane = tid & 63, wr = wid >> 2, wc = wid & 3, fr = lane & 15, fq = lane >> 4;
    const int K = g.K, nt = K / BK;
    unsigned voffA[2], voffB[2];
#pragma unroll
    for (int i = 0; i < 2; ++i) { int R, C; stage_rc(tid * 16 + i * 8192, R, C); const int Rb = Epi::PERM ? ((R & ~31) + perm32(R & 31)) : R;
        voffA[i] = (unsigned)(R * g.lda + C) * 2u; voffB[i] = (unsigned)(Rb * g.ldb + C) * 2u; }
    const size_t kstep = (size_t)(BK * 2);
    const size_t hstepA = (size_t)HALF * g.lda * 2, hstepB = (size_t)HALF * g.ldb * 2;
    const size_t tstepA = 2 * hstepA, tstepB = 2 * hstepB, pnA = (size_t)g.a_pn * 2;
    const unsigned ldsw = (unsigned)wid * 1024u;
    const int aoff = lds_byte(wr * 64 + fr, fq * 8), boff = lds_byte(wc * 32 + fr, fq * 8);
#define PG8_SA(b, h) (((b) * 2 + (h)) * HTB)
#define PG8_SB(b, h) ((4 + (b) * 2 + (h)) * HTB)
#define PG8_STAGE(bufoff, gbase, voff) do { _Pragma("unroll") for (int _i = 0; _i < 2; ++_i) \
        __builtin_amdgcn_global_load_lds((const unsigned*)((const char*)(gbase) + (voff)[_i]), (PG8_LAS unsigned*)(lds + (bufoff) + ldsw + _i * 8192), 16, 0, 0); } while (0)
#define PG8_LDA(dst, b, h) do { _Pragma("unroll") for (int m = 0; m < 4; ++m) _Pragma("unroll") for (int k = 0; k < 2; ++k) dst[m][k] = *(const PG8_LAS bf16x8*)(lds + PG8_SA(b, h) + aoff + m * 2048 + k * 1024); } while (0)
#define PG8_LDB(dst, b, h) do { _Pragma("unroll") for (int n = 0; n < 2; ++n) _Pragma("unroll") for (int k = 0; k < 2; ++k) dst[n][k] = *(const PG8_LAS bf16x8*)(lds + PG8_SB(b, h) + boff + n * 2048 + k * 1024); } while (0)
#define PG8_MMA(ai, bj, At, Bt) do { __builtin_amdgcn_s_setprio(1); _Pragma("unroll") for (int m = 0; m < 4; ++m) _Pragma("unroll") for (int n = 0; n < 2; ++n) _Pragma("unroll") for (int k = 0; k < 2; ++k) \
        acc[ai][bj][m][n] = __builtin_amdgcn_mfma_f32_16x16x32_bf16(Bt[n][k], At[m][k], acc[ai][bj][m][n], 0, 0, 0); __builtin_amdgcn_s_setprio(0); } while (0)
#define PG8_WAIT_V(n) asm volatile("s_waitcnt vmcnt(" #n ")" ::: "memory")
#define PG8_WAIT_L(n) asm volatile("s_waitcnt lgkmcnt(" #n ")" ::: "memory")
#define PG8_BAR __builtin_amdgcn_s_barrier()
#define PG8_SCHED __builtin_amdgcn_sched_barrier(0)
    Unit cur, nxt; int ui = 0;
    if (!S.next(0, cur)) return;
    f32x4 acc[2][2][4][2];
#pragma unroll
    for (int a = 0; a < 2; ++a)
#pragma unroll
        for (int b = 0; b < 2; ++b)
#pragma unroll
            for (int m = 0; m < 4; ++m)
#pragma unroll
                for (int n = 0; n < 2; ++n) acc[a][b][m][n] = (f32x4){0.f, 0.f, 0.f, 0.f};
    bf16x8 At[4][2], B0[2][2], B1[2][2];
    const char* cA = (const char*)g.A + (size_t)cur.pm * tstepA + (size_t)(cur.pn % g.nsplit_n) * pnA + (size_t)(cur.pn / g.nsplit_n) * g.kofs; const char* cB = (const char*)g.Bt + (size_t)(cur.pn % g.nsplit_n) * tstepB + (size_t)(cur.pn / g.nsplit_n) * g.kofs;
    S.a_ready(cur);
    if constexpr (SP2) {
        PG8_STAGE(PG8_SB(0, 0), cB, voffB); PG8_STAGE(PG8_SB(0, 1), cB + hstepB, voffB); PG8_STAGE(PG8_SA(0, 0), cA, voffA); PG8_STAGE(PG8_SA(0, 1), cA + hstepA, voffA);
        if (wr == 1) PG8_BAR;
        PG8_WAIT_V(2); PG8_BAR;
        PG8_STAGE(PG8_SB(1, 0), cB + kstep, voffB); PG8_STAGE(PG8_SA(1, 0), cA + kstep, voffA); PG8_STAGE(PG8_SB(1, 1), cB + hstepB + kstep, voffB);
        PG8_WAIT_V(6); PG8_BAR;
    } else {
        PG8_STAGE(PG8_SB(0, 0), cB, voffB); PG8_STAGE(PG8_SA(0, 0), cA, voffA); PG8_STAGE(PG8_SB(0, 1), cB + hstepB, voffB); PG8_STAGE(PG8_SA(0, 1), cA + hstepA, voffA);
        if (wr == 1) PG8_BAR;
        PG8_WAIT_V(4); PG8_BAR;
        PG8_STAGE(PG8_SB(1, 0), cB + kstep, voffB); PG8_STAGE(PG8_SA(1, 0), cA + kstep, voffA); PG8_STAGE(PG8_SB(1, 1), cB + hstepB + kstep, voffB);
        PG8_WAIT_V(6); PG8_BAR;
    }
    for (;;) {
        const bool has_next = S.next(ui + 1, nxt);
        const char* nA = has_next ? (const char*)g.A + (size_t)nxt.pm * tstepA + (size_t)(nxt.pn % g.nsplit_n) * pnA + (size_t)(nxt.pn / g.nsplit_n) * g.kofs : cA; const char* nB = has_next ? (const char*)g.Bt + (size_t)(nxt.pn % g.nsplit_n) * tstepB + (size_t)(nxt.pn / g.nsplit_n) * g.kofs : cB;
        const bool full_ = (cur.pm != g.half_pm);
        for (int t = 0; t < nt; t += 2) {
            const bool last = (t == nt - 2);
            const char* a1 = cA + (size_t)(t + 1) * kstep;
            const char* a2 = last ? nA : cA + (size_t)(t + 2) * kstep; const char* b2 = last ? nB : cB + (size_t)(t + 2) * kstep;
            const char* a3 = a2 + kstep; const char* b3 = b2 + kstep;
            if (last && has_next) S.a_ready(nxt);
            if constexpr (SP2) {
            PG8_LDB(B0, 0, 0); PG8_LDB(B1, 0, 1); PG8_SCHED; PG8_LDA(At, 0, 0); PG8_STAGE(PG8_SA(1, 1), a1 + hstepA, voffA);
            PG8_WAIT_V(8); PG8_WAIT_L(0); PG8_BAR; PG8_MMA(0, 0, At, B0); PG8_MMA(0, 1, At, B1); PG8_BAR; PG8_SCHED;
            PG8_LDA(At, 0, 1); PG8_STAGE(PG8_SB(0, 0), b2, voffB); PG8_STAGE(PG8_SB(0, 1), b2 + hstepB, voffB); PG8_STAGE(PG8_SA(0, 0), a2, voffA);
            PG8_WAIT_V(8); PG8_WAIT_L(0); PG8_BAR; if (full_) { PG8_MMA(1, 0, At, B0); PG8_MMA(1, 1, At, B1); } PG8_BAR; PG8_SCHED;
            PG8_LDB(B0, 1, 0); PG8_LDB(B1, 1, 1); PG8_SCHED; PG8_LDA(At, 1, 0); PG8_STAGE(PG8_SA(0, 1), a2 + hstepA, voffA);
            PG8_WAIT_V(8); PG8_WAIT_L(0); PG8_BAR; PG8_MMA(0, 0, At, B0); PG8_MMA(0, 1, At, B1); PG8_BAR; PG8_SCHED;
            PG8_LDA(At, 1, 1); PG8_STAGE(PG8_SB(1, 0), b3, voffB); PG8_STAGE(PG8_SB(1, 1), b3 + hstepB, voffB); PG8_STAGE(PG8_SA(1, 0), a3, voffA);
            PG8_WAIT_V(8); PG8_WAIT_L(0); PG8_BAR; if (full_) { PG8_MMA(1, 0, At, B0); PG8_MMA(1, 1, At, B1); } PG8_BAR; PG8_SCHED;
            } else {
            PG8_LDB(B0, 0, 0); PG8_SCHED; PG8_LDA(At, 0, 0); PG8_STAGE(PG8_SA(1, 1), a1 + hstepA, voffA);
            PG8_WAIT_L(8); PG8_BAR; PG8_WAIT_L(0); PG8_MMA(0, 0, At, B0); PG8_BAR; PG8_SCHED;
            PG8_LDB(B1, 0, 1); PG8_STAGE(PG8_SB(0, 0), b2, voffB);
            PG8_BAR; PG8_WAIT_L(0); PG8_MMA(0, 1, At, B1); PG8_BAR;
            PG8_LDA(At, 0, 1); PG8_STAGE(PG8_SA(0, 0), a2, voffA);
            PG8_BAR; PG8_WAIT_L(0); PG8_MMA(1, 0, At, B0); PG8_BAR; PG8_SCHED;
            PG8_STAGE(PG8_SB(0, 1), b2 + hstepB, voffB);
            PG8_WAIT_V(6); PG8_BAR; PG8_MMA(1, 1, At, B1); PG8_BAR;
            PG8_LDB(B0, 1, 0); PG8_SCHED; PG8_LDA(At, 1, 0); PG8_STAGE(PG8_SA(0, 1), a2 + hstepA, voffA);
            PG8_WAIT_L(8); PG8_BAR; PG8_WAIT_L(0); PG8_MMA(0, 0, At, B0); PG8_BAR; PG8_SCHED;
            PG8_LDB(B1, 1, 1); PG8_STAGE(PG8_SB(1, 0), b3, voffB);
            PG8_BAR; PG8_WAIT_L(0); PG8_MMA(0, 1, At, B1); PG8_BAR;
            PG8_LDA(At, 1, 1); PG8_STAGE(PG8_SA(1, 0), a3, voffA);
            PG8_BAR; PG8_WAIT_L(0); PG8_MMA(1, 0, At, B0); PG8_BAR; PG8_SCHED;
            PG8_STAGE(PG8_SB(1, 1), b3 + hstepB, voffB);
            PG8_WAIT_V(6); PG8_BAR; PG8_MMA(1, 1, At, B1); PG8_BAR;
            }
        }
        if constexpr (ALIGN_EPI) { if (wr == 0) PG8_BAR; }
        if constexpr (!Epi::AFTER_DRAIN) { E(acc, cur, wr, wc, fr, fq); S.done(cur); }
        if (!has_next) break;
#pragma unroll
        for (int a = 0; a < 2; ++a)
#pragma unroll
            for (int b = 0; b < 2; ++b)
#pragma unroll
                for (int m = 0; m < 4; ++m)
#pragma unroll
                    for (int n = 0; n < 2; ++n) acc[a][b][m][n] = (f32x4){0.f, 0.f, 0.f, 0.f};
        cur = nxt; cA = nA; cB = nB; ++ui;
        if constexpr (ALIGN_EPI) { if (wr == 1) PG8_BAR; }
    }
    PG8_WAIT_V(0);
    if constexpr (!ALIGN_EPI) { if (wr == 0) PG8_BAR; }
    PG8_BAR;
    if constexpr (Epi::AFTER_DRAIN) { E.fused(acc, cur, wr, wc, fr, fq, lds, wid, lane); S.done(cur); }
#undef PG8_SA
#undef PG8_SB
#undef PG8_STAGE
#undef PG8_LDA
#undef PG8_LDB
#undef PG8_MMA
#undef PG8_WAIT_V
#undef PG8_WAIT_L
#undef PG8_BAR
#undef PG8_SCHED
}
}

using pg8::bf16_t;
#define LAS __attribute__((address_space(3)))
#define GAS __attribute__((address_space(1)))
typedef float f32x4 __attribute__((ext_vector_type(4)));
typedef float f32x16 __attribute__((ext_vector_type(16)));
typedef short bf16x8 __attribute__((ext_vector_type(8)));
typedef short s16x4 __attribute__((ext_vector_type(4)));
typedef unsigned u32x4 __attribute__((ext_vector_type(4)));
typedef unsigned u32x2 __attribute__((ext_vector_type(2)));

constexpr int T_ = 4112, NB = 8, M_ = NB * T_, MP = 33024, D_ = 1024, NTHR = 512, NWV = 8;
constexpr float EPS = 1e-6f;
constexpr float QSCALE = 0.10206207261596577f * 1.4426950408889634f;
constexpr size_t MiB = 1u << 20;
constexpr size_t WS_CTL = 0, CTL_BYTES = 32768, WS_SSQM = 7 * MiB + 512 * 1024;
constexpr size_t WS_M = 10 * MiB;
constexpr size_t WS_SSQS = 75 * MiB;
constexpr size_t WS_COS = 1 * MiB, WS_SIN = 1 * MiB + 512 * 1024;
constexpr size_t WS_RSTDH = 2 * MiB, WS_RSTDQ = 2 * MiB + 256 * 1024, WS_RSTDKV = 2 * MiB + 512 * 1024;
constexpr size_t WS_DT = 3 * MiB, WS_KR = 5 * MiB + 256 * 1024, WS_SL = 3 * MiB, WS_SB = 4 * MiB + 512 * 1024;
constexpr size_t WS_H = 10 * MiB, WS_HB = 139 * MiB, WS_R = 203 * MiB + 512 * 1024;
constexpr size_t R_AB = 0, R_LAT = 129 * MiB, R_KV = 177 * MiB + 512 * 1024;
constexpr size_t R_U = 0;
constexpr size_t R_X = 0, R_G = 81 * MiB, R_XR = 162 * MiB;
constexpr size_t WS_NEED = WS_R + R_KV + 129 * MiB;
constexpr size_t WS_W = 80 * MiB;
constexpr size_t DO_Q = 30 * MiB;
constexpr size_t WS_PART = 112 * MiB;
constexpr size_t W_IN = 0, W_Q = 6 * MiB + 512 * 1024, W_KV = 7 * MiB + 640 * 1024, W_O = 8 * MiB + 640 * 1024, W_UP = 12 * MiB + 640 * 1024, W_DN = 20 * MiB + 640 * 1024;
constexpr size_t W_XY = 0, W_AI = 5 * MiB, W_RO = 5 * MiB + 640 * 1024;
constexpr int LDS_BYTES = 147456, LDS_CTL = 147200;

__device__ __forceinline__ unsigned xcc_id_() { return (unsigned)__builtin_amdgcn_s_getreg((3 << 11) | 20) & 0xFu; }
struct Params { const float* in[30]; float* out; unsigned char* ws; };
typedef const __attribute__((address_space(4))) unsigned char* PTAB;
__device__ __forceinline__ void* ldptr(PTAB kp, int k) { unsigned long long v = *(volatile const __attribute__((address_space(4))) unsigned long long*)(kp + 8 * k); asm volatile("" : "+s"(v)); return (void*)v; }
#define INP(k) ((const float*)ldptr(ptab, (k)))
#define OUTB ((unsigned char*)ldptr(ptab, 30))
#define WSP ((unsigned char*)ldptr(ptab, 31))

__device__ __forceinline__ float bflo(unsigned u) { return __uint_as_float(u << 16); }
__device__ __forceinline__ float bfhi(unsigned u) { return __uint_as_float(u & 0xffff0000u); }
__device__ __forceinline__ float bf1(bf16_t b) { return __uint_as_float((unsigned)b << 16); }
__device__ __forceinline__ unsigned pk2(float lo, float hi) {
    typedef float f2_t __attribute__((ext_vector_type(2))); typedef __bf16 b2_t __attribute__((ext_vector_type(2)));
    f2_t v = {lo, hi}; b2_t b = __builtin_convertvector(v, b2_t); return __builtin_bit_cast(unsigned, b); }
__device__ __forceinline__ float sigmoidf_(float x) { return __builtin_amdgcn_rcpf(1.0f + __expf(-x)); }
__device__ __forceinline__ float siluf_(float x) { return x * sigmoidf_(x); }
__device__ __forceinline__ float softplusf_(float x) { return x > 20.f ? x : __logf(1.0f + __expf(x)); }
__device__ __forceinline__ float gelu_tanh(float x) { const float y = 1.5957691216057308f * (x + 0.044715f * x * x * x); return x * __builtin_amdgcn_rcpf(1.0f + __expf(-y)); }
__device__ __forceinline__ float wave_sum(float v) {
#pragma unroll
    for (int o = 1; o < 64; o <<= 1) v += __shfl_xor(v, o);
    return v;
}
template <int CTRL> __device__ __forceinline__ float dpp_f(float v) { return __int_as_float(__builtin_amdgcn_update_dpp(0, __float_as_int(v), CTRL, 0xF, 0xF, true)); }
__device__ __forceinline__ float sum16(float v) { v += dpp_f<0xB1>(v); v += dpp_f<0x4E>(v); v += dpp_f<0x141>(v); v += dpp_f<0x140>(v); return v; }
__device__ __forceinline__ float sum8(float v) { v += dpp_f<0xB1>(v); v += dpp_f<0x4E>(v); v += dpp_f<0x141>(v); return v; }

enum { EP_IN = 0, EP_Q, EP_KV, EP_M, EP_UP, EP_XY, EP_AI, EP_PART };
template <int MODE> struct Epi {
    static constexpr bool PERM = true, AFTER_DRAIN = false;
    const float* rs; bf16_t* o0; bf16_t* o1; bf16_t* o2; float* ssq; const float* c0; const float* c1; const float* c2; const bf16_t* xr;
    __device__ __forceinline__ void operator()(const f32x4 (&acc)[2][2][4][2], const pg8::Unit& u, int wr, int wc, int fr, int fq) const {
        const int cw = wc * 32 + 8 * fq;
        float ai_ba[8], ai_bi[8], ai_sp[8];
        if constexpr (MODE == EP_AI) {
            const int ch = u.pn * 128 + cw;
#pragma unroll
            for (int e = 0; e < 8; ++e) { ai_ba[e] = *(const GAS float*)(c0 + ch + e); ai_bi[e] = *(const GAS float*)(c1 + ch + e); ai_sp[e] = -8.0f * softplusf_(-*(const GAS float*)(c2 + ch + e)); }
        }
        float scv[8];
        if constexpr (MODE == EP_IN || MODE == EP_KV || MODE == EP_UP || MODE == EP_XY || MODE == EP_Q) {
#pragma unroll
            for (int k = 0; k < 8; ++k) scv[k] = *(const GAS float*)(rs + u.pm * 256 + (k >> 2) * 128 + wr * 64 + (k & 3) * 16 + fr);
        }
#pragma unroll
        for (int ai = 0; ai < 2; ++ai) {
            u32x4 ai_xv[4];
            if constexpr (MODE == EP_AI) {
#pragma unroll
                for (int k = 0; k < 4; ++k) ai_xv[k] = *(const GAS u32x4*)(xr + (size_t)(u.pm * 256 + ai * 128 + wr * 64 + k * 16 + fr) * 1280 + u.pn * 128 + cw);
            }
#pragma unroll
            for (int m = 0; m < 4; ++m) {
                const int row = u.pm * 256 + ai * 128 + wr * 64 + m * 16 + fr;
                if constexpr (MODE == EP_PART) {
                    if (ai == 0) { GAS float* pp = (GAS float*)c0 + ((size_t)((u.pn >> 2) * 128 + wr * 64 + m * 16 + fr)) * 1024 + (u.pn & 3) * 256 + cw;
#pragma unroll
                        for (int bj = 0; bj < 2; ++bj) { *(GAS f32x4*)(pp + bj * 128) = acc[ai][bj][m][0]; *(GAS f32x4*)(pp + bj * 128 + 4) = acc[ai][bj][m][1]; } }
                } else
                if constexpr (MODE == EP_AI) {
                    const int ch = u.pn * 128 + cw;
                    const u32x4 xv = ai_xv[m];
                    const float xf[8] = {bflo(xv.x), bfhi(xv.x), bflo(xv.y), bfhi(xv.y), bflo(xv.z), bfhi(xv.z), bflo(xv.w), bfhi(xv.w)};
                    float la[8], uu[8];
#pragma unroll
                    for (int e = 0; e < 8; ++e) {
                        const float rp = acc[ai][0][m][e >> 2][e & 3] + ai_ba[e], ip = acc[ai][1][m][e >> 2][e & 3] + ai_bi[e];
                        const float r = sigmoidf_(rp), ig = sigmoidf_(ip);
                        const float l = r * ai_sp[e];
                        la[e] = l; uu[e] = __builtin_amdgcn_sqrtf(fmaxf(1.0f - __expf(2.0f * l), 0.f)) * (ig * xf[e]);
                    }
                    u32x4 w; w.x = pk2(la[0], la[1]); w.y = pk2(la[2], la[3]); w.z = pk2(la[4], la[5]); w.w = pk2(la[6], la[7]);
                    *(GAS u32x4*)(o0 + (size_t)row * 1280 + ch) = w;
                    w.x = pk2(uu[0], uu[1]); w.y = pk2(uu[2], uu[3]); w.z = pk2(uu[4], uu[5]); w.w = pk2(uu[6], uu[7]);
                    *(GAS u32x4*)(o1 + (size_t)row * 1280 + ch) = w;
                } else {
                    float sc = 1.0f;
                    if constexpr (MODE == EP_IN || MODE == EP_KV || MODE == EP_UP || MODE == EP_XY) sc = scv[ai * 4 + m];
                    if constexpr (MODE == EP_Q) sc = scv[ai * 4 + m] * QSCALE;
                    float sq = 0.f;
#pragma unroll
                    for (int bj = 0; bj < 2; ++bj) {
                        f32x4 v0 = acc[ai][bj][m][0] * sc, v1 = acc[ai][bj][m][1] * sc;
                        const int col = u.pn * 256 + bj * 128 + cw;
                        bf16_t* dst;
                        if constexpr (MODE == EP_IN) {
                            if (u.pn < 4) dst = o0 + (size_t)row * 2048 + col; else if (u.pn < 10) dst = o1 + (size_t)row * 1536 + (col - 1024); else dst = o2 + (size_t)row * 768 + (col - 2560);
                        } else if constexpr (MODE == EP_Q) {
                            dst = o0 + (size_t)row * 1536 + col;
                            const int d = col % 96;
                            if (d >= 64) {
                                const int t = row % T_, i0 = (d - 64) >> 1;
                                const f32x4 c = *(const GAS f32x4*)(c0 + t * 16 + i0), s = *(const GAS f32x4*)(c1 + t * 16 + i0);
                                const f32x4 a0 = v0, a1 = v1;
                                v0[0] = a0[0] * c[0] - a0[1] * s[0]; v0[1] = a0[1] * c[0] + a0[0] * s[0];
                                v0[2] = a0[2] * c[1] - a0[3] * s[1]; v0[3] = a0[3] * c[1] + a0[2] * s[1];
                                v1[0] = a1[0] * c[2] - a1[1] * s[2]; v1[1] = a1[1] * c[2] + a1[0] * s[2];
                                v1[2] = a1[2] * c[3] - a1[3] * s[3]; v1[3] = a1[3] * c[3] + a1[2] * s[3];
                            }
                        } else if constexpr (MODE == EP_KV) { dst = o0 + (size_t)row * 2048 + col;
                        } else if constexpr (MODE == EP_M) { dst = o0 + (size_t)row * 1024 + col;
                            sq += (v0[0] * v0[0] + v0[1] * v0[1]) + (v0[2] * v0[2] + v0[3] * v0[3]) + (v1[0] * v1[0] + v1[1] * v1[1]) + (v1[2] * v1[2] + v1[3] * v1[3]);
                        } else if constexpr (MODE == EP_UP) { dst = o0 + (size_t)row * 4096 + col;
#pragma unroll
                            for (int e = 0; e < 4; ++e) { const float a = fmaxf(v0[e], 0.f), b = fmaxf(v1[e], 0.f); v0[e] = a * a; v1[e] = b * b; }
                        } else {
                            if (u.pn < 5) dst = o0 + (size_t)row * 1280 + col;
                            else { dst = o1 + (size_t)row * 1280 + (col - 1280);
#pragma unroll
                                for (int e = 0; e < 4; ++e) { v0[e] = gelu_tanh(v0[e]); v1[e] = gelu_tanh(v1[e]); } }
                        }
                        u32x4 w; w.x = pk2(v0[0], v0[1]); w.y = pk2(v0[2], v0[3]); w.z = pk2(v1[0], v1[1]); w.w = pk2(v1[2], v1[3]);
                        if constexpr (MODE == EP_UP) __builtin_nontemporal_store(w, (GAS u32x4*)dst);
                        else *(GAS u32x4*)dst = w;
                    }
                    if constexpr (MODE == EP_M) {
                        sq += __shfl_xor(sq, 16); sq += __shfl_xor(sq, 32);
                        if (fq == 0) *(GAS float*)(ssq + (size_t)row * 16 + u.pn * 4 + wc) = sq;
                    }
                }
            }
        }
    }
};

struct TailOrder {
    int nN, G, c, pm;
    __device__ bool next(int i, pg8::Unit& u) const { const int pn = i * G + c; if (pn >= nN) return false; u.pm = pm; u.pn = pn; return true; }
    __device__ __forceinline__ void a_ready(const pg8::Unit&) const {}
    __device__ __forceinline__ void done(const pg8::Unit&) const {}
};
template <int MODE, int PART = 0> __device__ __forceinline__ void run_gemm(int wv_, LAS unsigned char* lds, const bf16_t* A, int lda, int a_pn, const bf16_t* Bt, int N, int K, const Epi<MODE>& E) {
    pg8::Gemm g{A, Bt, MP, N, K, lda, K, a_pn, MP / 256 - 1, 1 << 20, 0};
    int bid_ = __builtin_amdgcn_readfirstlane((int)*(volatile LAS unsigned*)(lds + LDS_CTL + 128)), gdim_ = (int)gridDim.x; asm volatile("" : "+s"(bid_), "+s"(gdim_));
    if constexpr (PART == 2) { TailOrder S{N / 256, gdim_, bid_, MP / 256 - 1}; pg8::gemm_phase<Epi<MODE>, TailOrder, true, true>(wv_, lds, g, S, E); }
    else { pg8::StaticOrder S; S.init(PART == 1 ? MP - 256 : MP, N, gdim_, bid_); pg8::gemm_phase<Epi<MODE>, pg8::StaticOrder, true, true>(wv_, lds, g, S, E); }
}

template <int MODE> __device__ __forceinline__ void run_gemm_tail(int wv_, LAS unsigned char* lds, const bf16_t* A, int lda, const bf16_t* Bt, int ldb, int ksz, int nks, const Epi<MODE>& E) {
    pg8::Gemm g{A, Bt, MP, 1024, ksz, lda, ldb, 0, MP / 256 - 1, 4, ksz * 2};
    int bid_ = __builtin_amdgcn_readfirstlane((int)*(volatile LAS unsigned*)(lds + LDS_CTL + 128)), gdim_ = (int)gridDim.x; asm volatile("" : "+s"(bid_), "+s"(gdim_));
    TailOrder S{4 * nks, gdim_, bid_, MP / 256 - 1}; pg8::gemm_phase<Epi<MODE>, TailOrder, true, true>(wv_, lds, g, S, E);
}

__device__ __forceinline__ int cmap(int kind, int n) {
    if (kind == 0) return n;
    if (kind == 1) {
        if (n < 2560) return n;
        const int j = n - 2560;
        if (j < 384) return 2576 + j;
        if (j < 640) return 2960 + (j - 384);
        if (j < 672) { const int i = (j - 640) >> 1; return (j & 1) ? 3216 + 16 + i : 3216 + i; }
        if (j < 688) return 2560 + (j - 672);
        return -1;
    }
    const int h = n / 96, d = n % 96;
    if (d < 64) return n;
    const int i = (d - 64) >> 1;
    return h * 96 + 64 + ((d & 1) ? 16 + i : i);
}
__device__ __forceinline__ void cvt_item(const float* W, int K, int Ns, bf16_t* WT, int row_off, int Nd, int kind, const float* g, int glim, LAS float* scr, int item, int lane) {
    const int nblk = Nd / 32, kb = item / nblk, nb = item % nblk, k0 = 64 * kb, n0 = 32 * nb;
    const int sc = cmap(kind, n0 + (lane & 31));
    {
        const int scc = sc >= 0 ? sc : 0; float wv32[32], gv32[32];
        const GAS float* wp = (const GAS float*)W + (size_t)(k0 + (lane >> 5)) * Ns + scc;
#pragma unroll
        for (int i = 0; i < 32; ++i) wv32[i] = wp[(size_t)(2 * i) * Ns];
#pragma unroll
        for (int i = 0; i < 32; ++i) { const int kk = k0 + 2 * i + (lane >> 5); gv32[i] = (g && kk < glim) ? *(const GAS float*)(g + kk) : 1.0f; }
#pragma unroll
        for (int i = 0; i < 32; ++i) { const int kk = 2 * i + (lane >> 5); scr[kk * 33 + (lane & 31)] = sc >= 0 ? wv32[i] * gv32[i] : 0.f; }
    }
    asm volatile("s_waitcnt lgkmcnt(0)" ::: "memory");
    const int c = lane & 7;
#pragma unroll
    for (int j = 0; j < 4; ++j) { const int n = (lane >> 3) + 8 * j; const LAS float* s = scr + (8 * c) * 33 + n;
        u32x4 o; o.x = pk2(s[0 * 33], s[1 * 33]); o.y = pk2(s[2 * 33], s[3 * 33]); o.z = pk2(s[4 * 33], s[5 * 33]); o.w = pk2(s[6 * 33], s[7 * 33]);
        *(u32x4*)(WT + (size_t)(row_off + n0 + n) * K + k0 + 8 * c) = o; }
    asm volatile("s_waitcnt lgkmcnt(0)" ::: "memory");
}
__device__ __forceinline__ void convert_layer(PTAB ptab, int wv_, int L, LAS unsigned char* lds) {
    const int lane = tid_opaque() & 63, wave = tid_opaque() >> 6;
    LAS float* scr = (LAS float*)(lds + wave * 16384);
    const int NGW = gridDim.x * NWV; int it = blockIdx.x * NWV + wave;
    bf16_t* W = (bf16_t*)(WSP + WS_W);
#define JOB(Wp, K, Ns, dstoff, roff, Nd, kind, g, glim) { const int ni_ = ((K) / 64) * ((Nd) / 32); for (; it < ni_; it += NGW) cvt_item((Wp), (K), (Ns), (bf16_t*)((unsigned char*)W + (dstoff)), (roff), (Nd), (kind), (g), (glim), scr, it, lane); it -= ni_; }
    if ((L & 1) == 0) {
        const int e = L >> 1;
        JOB(INP(8) + (size_t)e * 1024 * 3248, 1024, 3248, W_IN, 0, 3328, 1, INP(2) + L * 1024, 1024);
        JOB(INP(16) + (size_t)e * 384 * 1536, 384, 1536, W_Q, 0, 1536, 2, INP(15) + e * 384, 384);
        JOB(INP(18) + (size_t)e * 256 * 2048, 256, 2048, W_KV, 0, 2048, 0, INP(17) + e * 256, 256);
        JOB(INP(19) + (size_t)e * 2048 * 1024, 2048, 1024, W_O, 0, 1024, 0, INP(14) + e * 1024, 1024);
    } else {
        const int o = L >> 1;
        JOB(INP(20) + (size_t)o * 1024 * 1280, 1024, 1280, W_XY, 0, 1280, 0, INP(2) + L * 1024, 1024);
        JOB(INP(21) + (size_t)o * 1024 * 1280, 1024, 1280, W_XY, 1280, 1280, 0, INP(2) + L * 1024, 1024);
        for (int blk = 0; blk < 10; ++blk) {
            JOB(INP(24) + (size_t)(o * 10 + blk) * 128 * 128, 128, 128, W_AI, blk * 256, 128, 0, (const float*)nullptr, 0);
            JOB(INP(26) + (size_t)(o * 10 + blk) * 128 * 128, 128, 128, W_AI, blk * 256 + 128, 128, 0, (const float*)nullptr, 0);
        }
        JOB(INP(29) + (size_t)o * 1280 * 1024, 1280, 1024, W_RO, 0, 1024, 0, (const float*)nullptr, 0);
    }
    JOB(INP(6) + (size_t)L * 1024 * 4096, 1024, 4096, W_UP, 0, 4096, 0, INP(4) + L * 1024, 1024);
    JOB(INP(7) + (size_t)L * 4096 * 1024, 4096, 1024, W_DN, 0, 1024, 0, (const float*)nullptr, 0);
#undef JOB
}

__device__ __forceinline__ void setup_rows(PTAB ptab, int wv_) {
    const int lane = tid_opaque() & 63, gw = blockIdx.x * NWV + (tid_opaque() >> 6), NGW = gridDim.x * NWV;
    bf16_t* HB = (bf16_t*)(WSP + WS_HB); float* rstd = (float*)(WSP + WS_RSTDH);
    for (int row = gw; row < MP; row += NGW) {
        f32x4 v[4]; float s = 0.f;
        const float* src = nullptr;
        if (row < M_) { const int b = row / T_, t = row % T_; src = t < 16 ? INP(1) + (size_t)t * D_ : INP(0) + ((size_t)b * 4096 + (t - 16)) * D_; }
#pragma unroll
        for (int j = 0; j < 4; ++j) { v[j] = src ? *(const f32x4*)(src + 4 * lane + 256 * j) : (f32x4){0.f, 0.f, 0.f, 0.f}; s += (v[j][0] * v[j][0] + v[j][1] * v[j][1]) + (v[j][2] * v[j][2] + v[j][3] * v[j][3]); }
        s = wave_sum(s);
#pragma unroll
        for (int j = 0; j < 4; ++j) {
            u32x2 w; w.x = pk2(v[j][0], v[j][1]); w.y = pk2(v[j][2], v[j][3]); *(u32x2*)(HB + (size_t)row * D_ + 4 * lane + 256 * j) = w; }
        if (lane == 0) rstd[row] = __builtin_amdgcn_rsqf(s * (1.0f / D_) + EPS);
    }
    float* ct = (float*)(WSP + WS_COS); float* st = (float*)(WSP + WS_SIN);
    for (int i = blockIdx.x * NTHR + tid_opaque(); i < T_ * 16; i += gridDim.x * NTHR) {
        const int t = i >> 4, k = i & 15; const float inv = powf(10000.0f, -(float)(2 * k) / 32.0f); const float ang = (float)t * inv;
        ct[i] = cosf(ang); st[i] = sinf(ang);
    }
}
__device__ __forceinline__ void resnorm_phase(PTAB ptab, int wv_, LAS unsigned char* lds, const float* gpost, bool last, int r0, int r1, int cu_lo, bool dry = false) {
    const int vcu_ = __builtin_amdgcn_readfirstlane((int)*(volatile LAS unsigned*)(lds + LDS_CTL + 128));
    if (vcu_ < cu_lo) return;
    const int lane = tid_opaque() & 63, gw = (vcu_ - cu_lo) * NWV + (tid_opaque() >> 6), NGW = ((int)gridDim.x - cu_lo) * NWV;
    const GAS bf16_t* MB = (const GAS bf16_t*)(WSP + WS_M); GAS bf16_t* HB = (GAS bf16_t*)(WSP + WS_HB); GAS float* rstd = (GAS float*)(WSP + WS_RSTDH); const GAS float* ssq = (const GAS float*)(WSP + WS_SSQM);
    const GAS float* gp = (const GAS float*)gpost; GAS float* outp = (GAS float*)OUTB;
    f32x4 g[4];
#pragma unroll
    for (int j = 0; j < 4; ++j) g[j] = *(const GAS f32x4*)(gp + 4 * lane + 256 * j);
    constexpr int RB = 4;
    for (int row0 = r0 + gw; row0 < r1; row0 += RB * NGW) {
        u32x2 hb[RB][4], mb[RB][4]; float pq[RB];
#pragma unroll
        for (int q = 0; q < RB; ++q) { int row = row0 + q * NGW; row = row < r1 ? row : row0;
            pq[q] = lane < 16 ? ssq[(size_t)row * 16 + lane] : 0.f;
#pragma unroll
            for (int j = 0; j < 4; ++j) { const int c = 4 * lane + 256 * j; hb[q][j] = *(const GAS u32x2*)(HB + (size_t)row * D_ + c); mb[q][j] = *(const GAS u32x2*)(MB + (size_t)row * D_ + c); } }
#pragma unroll
        for (int q = 0; q < RB; ++q) { const int row = row0 + q * NGW;
            if (row < r1) {
                const float rm = __builtin_amdgcn_rsqf(wave_sum(pq[q]) * (1.0f / D_) + EPS);
                f32x4 v[4]; float sq = 0.f;
#pragma unroll
                for (int j = 0; j < 4; ++j) {
                    v[j][0] = bflo(hb[q][j].x) + bflo(mb[q][j].x) * rm * g[j][0]; v[j][1] = bfhi(hb[q][j].x) + bfhi(mb[q][j].x) * rm * g[j][1];
                    v[j][2] = bflo(hb[q][j].y) + bflo(mb[q][j].y) * rm * g[j][2]; v[j][3] = bfhi(hb[q][j].y) + bfhi(mb[q][j].y) * rm * g[j][3];
                    sq += (v[j][0] * v[j][0] + v[j][1] * v[j][1]) + (v[j][2] * v[j][2] + v[j][3] * v[j][3]); }
                sq = wave_sum(sq);
                if (dry) { if (sq == 12345.678f) rstd[row] = sq; }
                else if (!last) {
#pragma unroll
                    for (int j = 0; j < 4; ++j) { const int c = 4 * lane + 256 * j;
                        u32x2 w; w.x = pk2(v[j][0], v[j][1]); w.y = pk2(v[j][2], v[j][3]); *(GAS u32x2*)(HB + (size_t)row * D_ + c) = w; }
                    if (lane == 0) rstd[row] = __builtin_amdgcn_rsqf(sq * (1.0f / D_) + EPS);
                } else if (row < M_) {
                    const int b = row / T_, t = row % T_;
                    if (t >= 16) {
#pragma unroll
                        for (int j = 0; j < 4; ++j) *(GAS f32x4*)(outp + ((size_t)b * 4096 + (t - 16)) * D_ + 4 * lane + 256 * j) = v[j];
                    }
                }
            }
        }
    }
}
__device__ __forceinline__ void tail_reduce_resnorm(PTAB ptab, int wv_, const float* gpost, bool last, int nks) {
    const int lane = tid_opaque() & 63, gw = blockIdx.x * NWV + (tid_opaque() >> 6), NGW = gridDim.x * NWV;
    const GAS float* PART = (const GAS float*)(WSP + WS_PART); GAS bf16_t* HB = (GAS bf16_t*)(WSP + WS_HB); GAS float* rstd = (GAS float*)(WSP + WS_RSTDH);
    const GAS float* gp = (const GAS float*)gpost; GAS float* outp = (GAS float*)OUTB;
    for (int r = gw; r < 128; r += NGW) {
        const int row = MP - 256 + r;
        f32x4 m[4]; u32x2 hb[4]; f32x4 g[4];
#pragma unroll
        for (int j = 0; j < 4; ++j) { const int c = 4 * lane + 256 * j; m[j] = *(const GAS f32x4*)(PART + (size_t)r * 1024 + c); hb[j] = *(const GAS u32x2*)(HB + (size_t)row * D_ + c); g[j] = *(const GAS f32x4*)(gp + c); }
        for (int ks = 1; ks < nks; ++ks) {
#pragma unroll
            for (int j = 0; j < 4; ++j) m[j] += *(const GAS f32x4*)(PART + ((size_t)ks * 128 + r) * 1024 + 4 * lane + 256 * j); }
        float pq = 0.f;
#pragma unroll
        for (int j = 0; j < 4; ++j) pq += (m[j][0] * m[j][0] + m[j][1] * m[j][1]) + (m[j][2] * m[j][2] + m[j][3] * m[j][3]);
        const float rm = __builtin_amdgcn_rsqf(wave_sum(pq) * (1.0f / D_) + EPS);
        f32x4 v[4]; float sq = 0.f;
#pragma unroll
        for (int j = 0; j < 4; ++j) {
            v[j][0] = bflo(hb[j].x) + m[j][0] * rm * g[j][0]; v[j][1] = bfhi(hb[j].x) + m[j][1] * rm * g[j][1]; v[j][2] = bflo(hb[j].y) + m[j][2] * rm * g[j][2]; v[j][3] = bfhi(hb[j].y) + m[j][3] * rm * g[j][3];
            sq += (v[j][0] * v[j][0] + v[j][1] * v[j][1]) + (v[j][2] * v[j][2] + v[j][3] * v[j][3]); }
        sq = wave_sum(sq);
        if (!last) {
#pragma unroll
            for (int j = 0; j < 4; ++j) { u32x2 w; w.x = pk2(v[j][0], v[j][1]); w.y = pk2(v[j][2], v[j][3]); *(GAS u32x2*)(HB + (size_t)row * D_ + 4 * lane + 256 * j) = w; }
            if (lane == 0) rstd[row] = __builtin_amdgcn_rsqf(sq * (1.0f / D_) + EPS);
        } else {
            const int b = row / T_, t = row % T_;
#pragma unroll
            for (int j = 0; j < 4; ++j) *(GAS f32x4*)(outp + ((size_t)b * 4096 + (t - 16)) * D_ + 4 * lane + 256 * j) = v[j];
        }
    }
}
template <bool SILU> __device__ __forceinline__ void conv_pass(int wv_, const bf16_t* Xg, int ncols, const float* cwg, const float* cbg, bf16_t* Og) {
    const GAS bf16_t* X = (const GAS bf16_t*)Xg; GAS bf16_t* O = (GAS bf16_t*)Og; const GAS float* cw = (const GAS float*)cwg; const GAS float* cb = (const GAS float*)cbg;
    const int nchunk = ncols >> 3; constexpr int RUN = 48;
    for (int it = blockIdx.x * NTHR + tid_opaque(); it < nchunk * (MP / RUN); it += gridDim.x * NTHR) {
        const int c = (it % nchunk) * 8, r0 = (it / nchunk) * RUN;
        float w[4][8], bia[8];
#pragma unroll
        for (int i = 0; i < 4; ++i) { const f32x4 a = *(const GAS f32x4*)(cw + i * ncols + c), b = *(const GAS f32x4*)(cw + i * ncols + c + 4);
            w[i][0] = a[0]; w[i][1] = a[1]; w[i][2] = a[2]; w[i][3] = a[3]; w[i][4] = b[0]; w[i][5] = b[1]; w[i][6] = b[2]; w[i][7] = b[3]; }
        { const f32x4 a = *(const GAS f32x4*)(cb + c), b = *(const GAS f32x4*)(cb + c + 4); bia[0] = a[0]; bia[1] = a[1]; bia[2] = a[2]; bia[3] = a[3]; bia[4] = b[0]; bia[5] = b[1]; bia[6] = b[2]; bia[7] = b[3]; }
        u32x4 x1, x2, x3;
        { const int ra = r0 - 1 > 0 ? r0 - 1 : 0, rb = r0 - 2 > 0 ? r0 - 2 : 0, rc = r0 - 3 > 0 ? r0 - 3 : 0;
          x1 = *(const GAS u32x4*)(X + (size_t)ra * ncols + c); x2 = *(const GAS u32x4*)(X + (size_t)rb * ncols + c); x3 = *(const GAS u32x4*)(X + (size_t)rc * ncols + c); }
        for (int rr = 0; rr < RUN; rr += 4) {
            u32x4 xn[4];
#pragma unroll
            for (int k = 0; k < 4; ++k) xn[k] = *(const GAS u32x4*)(X + (size_t)(r0 + rr + k) * ncols + c);
#pragma unroll
            for (int k = 0; k < 4; ++k) {
                const int row = r0 + rr + k, t = row % T_;
                const float m1 = t >= 1 ? 1.f : 0.f, m2 = t >= 2 ? 1.f : 0.f, m3 = t >= 3 ? 1.f : 0.f;
                const u32x4 x0 = xn[k]; float a[8];
#define CV_(e, f0, f1, f2, f3) a[e] = bia[e] + w[3][e] * (f0) + m1 * (w[2][e] * (f1)) + m2 * (w[1][e] * (f2)) + m3 * (w[0][e] * (f3))
                CV_(0, bflo(x0.x), bflo(x1.x), bflo(x2.x), bflo(x3.x)); CV_(1, bfhi(x0.x), bfhi(x1.x), bfhi(x2.x), bfhi(x3.x));
                CV_(2, bflo(x0.y), bflo(x1.y), bflo(x2.y), bflo(x3.y)); CV_(3, bfhi(x0.y), bfhi(x1.y), bfhi(x2.y), bfhi(x3.y));
                CV_(4, bflo(x0.z), bflo(x1.z), bflo(x2.z), bflo(x3.z)); CV_(5, bfhi(x0.z), bfhi(x1.z), bfhi(x2.z), bfhi(x3.z));
                CV_(6, bflo(x0.w), bflo(x1.w), bflo(x2.w), bflo(x3.w)); CV_(7, bfhi(x0.w), bfhi(x1.w), bfhi(x2.w), bfhi(x3.w));
#undef CV_
                if (SILU) {
#pragma unroll
                    for (int e2 = 0; e2 < 8; ++e2) a[e2] = siluf_(a[e2]); }
                u32x4 o; o.x = pk2(a[0], a[1]); o.y = pk2(a[2], a[3]); o.z = pk2(a[4], a[5]); o.w = pk2(a[6], a[7]);
                *(GAS u32x4*)(O + (size_t)row * ncols + c) = o;
                x3 = x2; x2 = x1; x1 = x0;
            }
        }
    }
}
__device__ __forceinline__ void prep_phase(PTAB ptab, int wv_, int e) {
    const int lane = tid_opaque() & 63, gw = blockIdx.x * NWV + (tid_opaque() >> 6), NGW = gridDim.x * NWV;
    const bf16_t* LAT = (const bf16_t*)(WSP + WS_R + R_LAT);
    float* rq = (float*)(WSP + WS_RSTDQ); float* rkv = (float*)(WSP + WS_RSTDKV); float* DT = (float*)(WSP + WS_DT); bf16_t* KR = (bf16_t*)(WSP + WS_KR);
    const float* ct = (const float*)(WSP + WS_COS); const float* st = (const float*)(WSP + WS_SIN);
    const float* dtb = INP(11) + e * 16;
    for (int row0 = gw; row0 < MP; row0 += 4 * NGW) {
        unsigned wq[4][3], wk[4][2], wx[4];
#pragma unroll
        for (int q = 0; q < 4; ++q) { int row = row0 + q * NGW; row = row < MP ? row : row0; const GAS bf16_t* lr = (const GAS bf16_t*)LAT + (size_t)row * 768;
#pragma unroll
            for (int j = 0; j < 3; ++j) wq[q][j] = *(const GAS unsigned*)(lr + 2 * lane + 128 * j);
#pragma unroll
            for (int j = 0; j < 2; ++j) wk[q][j] = *(const GAS unsigned*)(lr + 384 + 2 * lane + 128 * j);
            wx[q] = *(const GAS unsigned*)(lr + 640 + 2 * (lane & 31)); }
#pragma unroll
        for (int q = 0; q < 4; ++q) { const int row = row0 + q * NGW;
            if (row < MP) {
                float sq = 0.f, sk = 0.f;
#pragma unroll
                for (int j = 0; j < 3; ++j) { const float a = bflo(wq[q][j]), b = bfhi(wq[q][j]); sq += a * a + b * b; }
#pragma unroll
                for (int j = 0; j < 2; ++j) { const float a = bflo(wk[q][j]), b = bfhi(wk[q][j]); sk += a * a + b * b; }
                sq = wave_sum(sq); sk = wave_sum(sk);
                if (lane == 0) { *(GAS float*)(rq + row) = __builtin_amdgcn_rsqf(sq * (1.0f / 384.f) + EPS); *(GAS float*)(rkv + row) = __builtin_amdgcn_rsqf(sk * (1.0f / 256.f) + EPS); }
                const int t = row % T_;
                if (lane < 16) { const float x1 = bflo(wx[q]), x2 = bfhi(wx[q]), c = *(const GAS float*)(ct + t * 16 + lane), sn = *(const GAS float*)(st + t * 16 + lane);
                    *(GAS unsigned*)(KR + (size_t)row * 32 + 2 * lane) = pk2(x1 * c - x2 * sn, x2 * c + x1 * sn); }
                else if (lane < 24) { const int h2 = 2 * (lane - 16);
                    *(GAS float*)(DT + (size_t)row * 16 + h2) = softplusf_(bflo(wx[q]) + *(const GAS float*)(dtb + h2)); *(GAS float*)(DT + (size_t)row * 16 + h2 + 1) = softplusf_(bfhi(wx[q]) + *(const GAS float*)(dtb + h2 + 1)); }
            }
        }
    }
    conv_pass<true>(wv_, (const bf16_t*)(WSP + WS_R + R_KV), 1536, INP(9) + (size_t)e * 4 * 1536, INP(10) + (size_t)e * 1536, (bf16_t*)(OUTB + DO_Q));
}
__device__ __forceinline__ void fix_phase(PTAB ptab, int wv_, bool dry = false) {
    const int lane = tid_opaque() & 63, gw = blockIdx.x * NWV + (tid_opaque() >> 6), NGW = gridDim.x * NWV;
    bf16_t* AB = (bf16_t*)(WSP + WS_R + R_AB); float* ssq = (float*)(WSP + WS_SSQS);
    for (int row0 = gw; row0 < MP; row0 += 4 * NGW) {
        float pq[4]; u32x4 v[4][2];
#pragma unroll
        for (int q = 0; q < 4; ++q) { int row = row0 + q * NGW; row = row < MP ? row : row0;
            pq[q] = lane < 32 ? *(const GAS float*)(ssq + (size_t)row * 32 + lane) : 0.f;
#pragma unroll
            for (int j = 0; j < 2; ++j) v[q][j] = *(const GAS u32x4*)(AB + (size_t)row * 2048 + 8 * lane + 512 * j); }
#pragma unroll
        for (int q = 0; q < 4; ++q) { const int row = row0 + q * NGW;
            if (row < MP) { const float rs = __builtin_amdgcn_rsqf(wave_sum(pq[q]) * (1.0f / 1024.f) + EPS);
#pragma unroll
                for (int j = 0; j < 2; ++j) { u32x4 w = v[q][j];
                    w.x = pk2(bflo(w.x) * rs, bfhi(w.x) * rs); w.y = pk2(bflo(w.y) * rs, bfhi(w.y) * rs); w.z = pk2(bflo(w.z) * rs, bfhi(w.z) * rs); w.w = pk2(bflo(w.w) * rs, bfhi(w.w) * rs);
                    if (!dry || w.x == 0x12345678u) *(GAS u32x4*)(AB + (size_t)row * 2048 + 8 * lane + 512 * j) = w; } }
        }
    }
}
__device__ __forceinline__ void rgconv_phase(PTAB ptab, int wv_, int o) {
    conv_pass<false>(wv_, (const bf16_t*)(WSP + WS_R + R_X), 1280, INP(22) + (size_t)o * 4 * 1280, INP(23) + (size_t)o * 1280, (bf16_t*)(WSP + WS_R + R_XR));
}
constexpr int SC_NC = 33;
__device__ __forceinline__ void scan_a_phase(PTAB ptab, int wv_) {
    const GAS bf16_t* LA = (const GAS bf16_t*)(WSP + WS_R + R_X); const GAS bf16_t* U = (const GAS bf16_t*)(OUTB + DO_Q);
    GAS float* SL = (GAS float*)(WSP + WS_SL); GAS float* SB = (GAS float*)(WSP + WS_SB);
    for (int it = blockIdx.x * NTHR + tid_opaque(); it < NB * SC_NC * 320; it += gridDim.x * NTHR) {
        const int c4 = (it % 320) * 4, bc = it / 320, ck = bc % SC_NC, b = bc / SC_NC;
        const int t0 = ck * 128, n = (T_ - t0) < 128 ? (T_ - t0) : 128;
        const size_t base = ((size_t)b * T_ + t0) * 1280 + c4;
        float h[4] = {0.f, 0.f, 0.f, 0.f}, sl[4] = {0.f, 0.f, 0.f, 0.f};
        for (int l0 = 0; l0 < n; l0 += 8) {
            u32x2 av[8], uv[8];
#pragma unroll
            for (int k = 0; k < 8; ++k) { av[k] = *(const GAS u32x2*)(LA + base + (size_t)(l0 + k) * 1280); uv[k] = *(const GAS u32x2*)(U + base + (size_t)(l0 + k) * 1280); }
#pragma unroll
            for (int k = 0; k < 8; ++k) { const float l0f = bflo(av[k].x), l1 = bfhi(av[k].x), l2 = bflo(av[k].y), l3 = bfhi(av[k].y);
                h[0] = __expf(l0f) * h[0] + bflo(uv[k].x); h[1] = __expf(l1) * h[1] + bfhi(uv[k].x); h[2] = __expf(l2) * h[2] + bflo(uv[k].y); h[3] = __expf(l3) * h[3] + bfhi(uv[k].y);
                sl[0] += l0f; sl[1] += l1; sl[2] += l2; sl[3] += l3; }
        }
        *(GAS f32x4*)(SL + (size_t)bc * 1280 + c4) = (f32x4){sl[0], sl[1], sl[2], sl[3]};
        *(GAS f32x4*)(SB + (size_t)bc * 1280 + c4) = (f32x4){h[0], h[1], h[2], h[3]};
    }
}
__device__ __forceinline__ void scan_c_phase(PTAB ptab, int wv_, bool dry = false) {
    const GAS bf16_t* LA = (const GAS bf16_t*)(WSP + WS_R + R_X); GAS bf16_t* U = (GAS bf16_t*)(OUTB + DO_Q); const GAS bf16_t* G = (const GAS bf16_t*)(WSP + WS_R + R_G);
    const GAS float* SL = (const GAS float*)(WSP + WS_SL); const GAS float* SB = (const GAS float*)(WSP + WS_SB);
    for (int it = blockIdx.x * NTHR + tid_opaque(); it < NB * SC_NC * 320; it += gridDim.x * NTHR) {
        const int c4 = (it % 320) * 4, bc = it / 320, ck = bc % SC_NC, b = bc / SC_NC;
        const int t0 = ck * 128, n = (T_ - t0) < 128 ? (T_ - t0) : 128;
        const size_t base = ((size_t)b * T_ + t0) * 1280 + c4;
        float h[4] = {0.f, 0.f, 0.f, 0.f};
        for (int j0 = 0; j0 < ck; j0 += 4) {
            f32x4 sl[4], sb[4];
#pragma unroll
            for (int k = 0; k < 4; ++k) { const int j = (j0 + k) < ck ? (j0 + k) : (ck - 1); sl[k] = *(const GAS f32x4*)(SL + (size_t)(b * SC_NC + j) * 1280 + c4); sb[k] = *(const GAS f32x4*)(SB + (size_t)(b * SC_NC + j) * 1280 + c4); }
#pragma unroll
            for (int k = 0; k < 4; ++k) if (j0 + k < ck) { h[0] = __expf(sl[k][0]) * h[0] + sb[k][0]; h[1] = __expf(sl[k][1]) * h[1] + sb[k][1]; h[2] = __expf(sl[k][2]) * h[2] + sb[k][2]; h[3] = __expf(sl[k][3]) * h[3] + sb[k][3]; }
        }
        for (int l0 = 0; l0 < n; l0 += 8) {
            u32x2 av[8], uv[8], gv[8];
#pragma unroll
            for (int k = 0; k < 8; ++k) { const size_t o = base + (size_t)(l0 + k) * 1280; av[k] = *(const GAS u32x2*)(LA + o); uv[k] = *(const GAS u32x2*)(U + o); gv[k] = *(const GAS u32x2*)(G + o); }
#pragma unroll
            for (int k = 0; k < 8; ++k) {
                h[0] = __expf(bflo(av[k].x)) * h[0] + bflo(uv[k].x); h[1] = __expf(bfhi(av[k].x)) * h[1] + bfhi(uv[k].x); h[2] = __expf(bflo(av[k].y)) * h[2] + bflo(uv[k].y); h[3] = __expf(bfhi(av[k].y)) * h[3] + bfhi(uv[k].y);
                u32x2 w; w.x = pk2(h[0] * bflo(gv[k].x), h[1] * bfhi(gv[k].x)); w.y = pk2(h[2] * bflo(gv[k].y), h[3] * bfhi(gv[k].y));
                if (!dry || w.x == 0x12345678u) *(GAS u32x2*)(U + base + (size_t)(l0 + k) * 1280) = w; }
        }
    }
}

typedef short v4i16_t __attribute__((ext_vector_type(4)));
__device__ __forceinline__ s16x4 vtr(const LAS unsigned char* p) { return __builtin_bit_cast(s16x4, __builtin_amdgcn_ds_read_tr16_b64_v4i16((LAS v4i16_t*)p)); }
#define MFMA32(a, b, c) __builtin_amdgcn_mfma_f32_32x32x16_bf16((a), (b), (c), 0, 0, 0)
constexpr int SD_BP = 272, SD_XP = 192;
constexpr int SD_B = 0, SD_C = 128 * SD_BP, SD_X = 2 * 128 * SD_BP, SD_XS = SD_X + 128 * SD_XP, SD_S = SD_XS + 128 * SD_XP, SD_ACS = SD_S + 64 * SD_BP, SD_DT = SD_ACS + 512, SD_F = SD_DT + 512, SD_END = SD_F + 512;
static_assert(SD_END <= LDS_CTL, "SSD LDS map");
__device__ __forceinline__ void ssd_phase(PTAB ptab, int wv_, int e, LAS unsigned char* lds, bool dry = false) {
    const int tid = tid_opaque(), lane = tid & 63, wid = __builtin_amdgcn_readfirstlane(tid >> 6), r = lane & 31, hh = lane >> 5;
    const int lb = wid & 3, pb = wid >> 2, q4 = (lane & 15) >> 2, p4 = lane & 3, blk = (lane >> 4) & 1;
    const bf16_t* XC = (const bf16_t*)(OUTB + DO_Q); const float* DT = (const float*)(WSP + WS_DT);
    bf16_t* AB = (bf16_t*)(WSP + WS_R + R_AB); float* ssq = (float*)(WSP + WS_SSQS);
    LAS float* acs = (LAS float*)(lds + SD_ACS); LAS float* dts = (LAS float*)(lds + SD_DT); LAS float* fs = (LAS float*)(lds + SD_F);
    for (int u2 = blockIdx.x; u2 < NB * 32; u2 += gridDim.x) {
        const int u = u2 >> 1, half = u2 & 1;
        const int b = u >> 4, h = u & 15, g = h >> 3;
        const float ah = -__expf(INP(12)[e * 16 + h]), Dh = INP(13)[e * 16 + h];
        const size_t rowbase = (size_t)b * T_;
        f32x16 st;
#pragma unroll
        for (int i = 0; i < 16; ++i) st[i] = 0.f;
        __syncthreads();
        for (int i = tid; i < 64 * SD_BP / 4; i += NTHR) ((LAS unsigned*)(lds + SD_S))[i] = 0u;
        for (int ck = 0; ck < (half ? 33 : 17); ++ck) {
            const bool light = half && ck < 17;
            const int t0 = ck * 128, nv = (T_ - t0) < 128 ? (T_ - t0) : 128;
            u32x4 gb[4], gc[4], gx[2];
#pragma unroll
            for (int k = 0; k < 4; ++k) { const int c = tid + 512 * k, row = c >> 4, cc = c & 15; gb[k] = (u32x4){0u, 0u, 0u, 0u}; gc[k] = gb[k];
                if (row < nv) { const bf16_t* src = XC + (rowbase + t0 + row) * 1536 + 1024 + g * 128 + cc * 8; gb[k] = *(const u32x4*)src; if (!light) gc[k] = *(const u32x4*)(src + 256); } }
#pragma unroll
            for (int k = 0; k < 2; ++k) { const int c = tid + 512 * k, row = c >> 3, cc = c & 7; gx[k] = (u32x4){0u, 0u, 0u, 0u};
                if (row < nv) gx[k] = *(const u32x4*)(XC + (rowbase + t0 + row) * 1536 + h * 64 + cc * 8); }
            float dta = 0.f, dtb = 0.f;
            if (wid == 0) { if (2 * lane < nv) dta = DT[(rowbase + t0 + 2 * lane) * 16 + h]; if (2 * lane + 1 < nv) dtb = DT[(rowbase + t0 + 2 * lane + 1) * 16 + h]; }
            __syncthreads();
#pragma unroll
            for (int k = 0; k < 4; ++k) { const int c = tid + 512 * k, row = c >> 4, cc = c & 15;
                *(LAS u32x4*)(lds + SD_B + row * SD_BP + cc * 16) = gb[k]; if (!light) *(LAS u32x4*)(lds + SD_C + row * SD_BP + cc * 16) = gc[k]; }
#pragma unroll
            for (int k = 0; k < 2; ++k) { const int c = tid + 512 * k, row = c >> 3, cc = c & 7; *(LAS u32x4*)(lds + SD_X + row * SD_XP + cc * 16) = gx[k]; }
            if (wid == 0) {
                const float d0 = dta, d1 = dtb, v0 = d0 * ah, v1 = d1 * ah; float sc = v0 + v1;
                dts[2 * lane] = d0; dts[2 * lane + 1] = d1;
#pragma unroll
                for (int o = 1; o < 64; o <<= 1) { const float t = __shfl_up(sc, o); if (lane >= o) sc += t; }
                const float a1 = sc, a0 = sc - v1, ae = __shfl(sc, 63);
                acs[2 * lane + 1] = a1; acs[2 * lane] = a0;
                fs[2 * lane] = d0 * __expf(ae - a0); fs[2 * lane + 1] = d1 * __expf(ae - a1);
            }
            __syncthreads();
            const float aend = acs[127];
#pragma unroll
            for (int k = 0; k < 2; ++k) { const int c = tid + 512 * k, row = c >> 3, cc = c & 7; const float f = fs[row]; const u32x4 xv = gx[k]; u32x4 o;
                o.x = pk2(bflo(xv.x) * f, bfhi(xv.x) * f); o.y = pk2(bflo(xv.y) * f, bfhi(xv.y) * f); o.z = pk2(bflo(xv.z) * f, bfhi(xv.z) * f); o.w = pk2(bflo(xv.w) * f, bfhi(xv.w) * f);
                *(LAS u32x4*)(lds + SD_XS + row * SD_XP + cc * 16) = o; }
            __syncthreads();
            f32x16 y;
            if (!light) {
            bf16x8 cf[8];
#pragma unroll
            for (int ks = 0; ks < 8; ++ks) cf[ks] = *(const LAS bf16x8*)(lds + SD_C + (32 * lb + r) * SD_BP + (16 * ks + 8 * hh) * 2);
#pragma unroll
            for (int i = 0; i < 16; ++i) y[i] = 0.f;
#pragma unroll
            for (int ks = 0; ks < 8; ++ks) { const bf16x8 sf = *(const LAS bf16x8*)(lds + SD_S + (32 * pb + r) * SD_BP + (16 * ks + 8 * hh) * 2); y = MFMA32(sf, cf[ks], y); }
            const float al = acs[32 * lb + r], eal = __expf(al);
#pragma unroll
            for (int i = 0; i < 16; ++i) y[i] *= eal;
            for (int sb = 0; sb <= lb; ++sb) {
                f32x16 cb;
#pragma unroll
                for (int i = 0; i < 16; ++i) cb[i] = 0.f;
#pragma unroll
                for (int ks = 0; ks < 8; ++ks) { const bf16x8 bfr = *(const LAS bf16x8*)(lds + SD_B + (32 * sb + r) * SD_BP + (16 * ks + 8 * hh) * 2); cb = MFMA32(bfr, cf[ks], cb); }
#pragma unroll
                for (int i = 0; i < 16; ++i) { const int sl = (i & 3) + 8 * (i >> 2) + 4 * hh, s = 32 * sb + sl;
                    const float w = __expf(al - acs[s]) * dts[s]; const bool keep = (sb < lb) || (sl <= r); cb[i] = keep ? cb[i] * w : 0.f; }
#pragma unroll
                for (int s2 = 0; s2 < 2; ++s2) {
                    u32x4 pw; pw.x = pk2(cb[8 * s2], cb[8 * s2 + 1]); pw.y = pk2(cb[8 * s2 + 2], cb[8 * s2 + 3]); pw.z = pk2(cb[8 * s2 + 4], cb[8 * s2 + 5]); pw.w = pk2(cb[8 * s2 + 6], cb[8 * s2 + 7]);
                    const LAS unsigned char* xa = lds + SD_X + (32 * sb + 16 * s2 + 4 * hh + q4) * SD_XP + pb * 64 + 32 * blk + 8 * p4;
                    const s16x4 lo = vtr(xa), hi = vtr(xa + 8 * SD_XP);
                    const bf16x8 xf = {lo[0], lo[1], lo[2], lo[3], hi[0], hi[1], hi[2], hi[3]};
                    y = MFMA32(xf, __builtin_bit_cast(bf16x8, pw), y);
                }
            }
            }
            { const float cd = __expf(aend);
#pragma unroll
              for (int i = 0; i < 16; ++i) st[i] *= cd;
#pragma unroll
              for (int ks = 0; ks < 8; ++ks) {
                  const LAS unsigned char* ba = lds + SD_B + (16 * ks + 8 * hh + q4) * SD_BP + lb * 64 + 32 * blk + 8 * p4;
                  const s16x4 blo = vtr(ba), bhi = vtr(ba + 4 * SD_BP);
                  const bf16x8 bt = {blo[0], blo[1], blo[2], blo[3], bhi[0], bhi[1], bhi[2], bhi[3]};
                  const LAS unsigned char* xa = lds + SD_XS + (16 * ks + 8 * hh + q4) * SD_XP + pb * 64 + 32 * blk + 8 * p4;
                  const s16x4 xlo = vtr(xa), xhi = vtr(xa + 4 * SD_XP);
                  const bf16x8 xs = {xlo[0], xlo[1], xlo[2], xlo[3], xhi[0], xhi[1], xhi[2], xhi[3]};
                  st = MFMA32(bt, xs, st);
              } }
            if (!light) { const int l = 32 * lb + r; float q = 0.f;
              if (l < nv) {
#pragma unroll
                  for (int gq = 0; gq < 4; ++gq) { const int p0 = 32 * pb + 8 * gq + 4 * hh;
                      const u32x2 xv = *(const LAS u32x2*)(lds + SD_X + l * SD_XP + p0 * 2);
                      u32x2* zp = (u32x2*)(AB + (rowbase + t0 + l) * 2048 + h * 64 + p0); const u32x2 zv = *zp;
                      const float o0 = (y[4 * gq] + Dh * bflo(xv.x)) * siluf_(bflo(zv.x)), o1 = (y[4 * gq + 1] + Dh * bfhi(xv.x)) * siluf_(bfhi(zv.x));
                      const float o2 = (y[4 * gq + 2] + Dh * bflo(xv.y)) * siluf_(bflo(zv.y)), o3 = (y[4 * gq + 3] + Dh * bfhi(xv.y)) * siluf_(bfhi(zv.y));
                      u32x2 w; w.x = pk2(o0, o1); w.y = pk2(o2, o3); if (!dry) *zp = w;
                      q += (o0 * o0 + o1 * o1) + (o2 * o2 + o3 * o3); }
              }
              q += __shfl_xor(q, 32);
              if (hh == 0 && l < nv && !dry) ssq[(rowbase + t0 + l) * 32 + h * 2 + pb] = q; }
            __syncthreads();
#pragma unroll
            for (int gq = 0; gq < 4; ++gq) { u32x2 w; w.x = pk2(st[4 * gq], st[4 * gq + 1]); w.y = pk2(st[4 * gq + 2], st[4 * gq + 3]);
                *(LAS u32x2*)(lds + SD_S + (32 * pb + r) * SD_BP + (32 * lb + 8 * gq + 4 * hh) * 2) = w; }
        }
    }
}

constexpr int AT_KP = 208, AT_VP = 192, AT_KB = 64 * AT_KP, AT_VB = 64 * AT_VP;
constexpr int AT_NQB = 17, AT_NU = NB * 16 * AT_NQB;
__device__ __forceinline__ void attn_phase(PTAB ptab, int wv_, LAS unsigned char* lds, unsigned* counter) {
    const int tid = tid_opaque(), lane = tid & 63, wid = __builtin_amdgcn_readfirstlane(tid >> 6), r = lane & 31, hh = lane >> 5;
    const bf16_t* Q = (const bf16_t*)(OUTB + DO_Q); const bf16_t* KV = (const bf16_t*)(WSP + WS_R + R_KV); const bf16_t* KR = (const bf16_t*)(WSP + WS_KR);
    bf16_t* AB = (bf16_t*)(WSP + WS_R + R_AB);
    LAS unsigned* slot = (LAS unsigned*)(lds + 2 * AT_KB + 2 * AT_VB);
    const unsigned xcc0 = xcc_id_() & 7u;
    if (wid < 4) __builtin_amdgcn_s_setprio(2);
    const int c0r = tid >> 4, c0c = tid & 15, c1r = c0r + 32, rkr = (tid & 255) >> 2, rkc = tid & 3;
    const int d0off = c0c < 8 ? c0r * AT_KP + c0c * 16 : 2 * AT_KB + c0r * AT_VP + (c0c - 8) * 16;
    const int d1off = c0c < 8 ? c1r * AT_KP + c0c * 16 : 2 * AT_KB + c1r * AT_VP + (c0c - 8) * 16;
    const int dboff = c0c < 8 ? AT_KB : AT_VB, drope = rkr * AT_KP + 128 + rkc * 16;
    const int q4 = (lane & 15) >> 2, p4 = lane & 3, blk = (lane >> 4) & 1;
    for (int xo = 0; xo < 1; ++xo) {
    const unsigned xcc = 0u; (void)xcc0;
    for (;;) {
        __syncthreads();
        if (tid == 0) *slot = atomicAdd(counter + 16 * xcc, 1u);
        __syncthreads();
        const unsigned ui = *slot;
        if (ui >= (unsigned)AT_NU) break;
        const int qb = 16 - (int)(ui >> 7), bh = (int)(ui & 127u), b = bh >> 4, h = bh & 15;
        const int q0 = qb == 0 ? 0 : 16 + 256 * (qb - 1); const size_t rowbase = (size_t)b * T_;
        const int qend = qb == 0 ? 16 : q0 + 256, nt = (qend + 63) >> 6;
        const int qrow = q0 + 32 * wid + r, qrc = qrow < T_ ? qrow : (T_ - 1);
        const int qwmin = q0 + 32 * wid, qwmax = qwmin + 31;
        bf16x8 qf[6];
        { const bf16_t* qp = Q + (rowbase + qrc) * 1536 + h * 96 + 8 * hh;
#pragma unroll
          for (int ks = 0; ks < 6; ++ks) qf[ks] = *(const GAS bf16x8*)(qp + 16 * ks); }
        float m_run = 0.f, l_run = 0.f; f32x16 o[2];
#pragma unroll
        for (int i = 0; i < 16; ++i) { o[0][i] = 0.f; o[1][i] = 0.f; }
        u32x4 gk0[2], gk1[2], gv[2];
#define AT_BAR() asm volatile("s_waitcnt lgkmcnt(0)\n\ts_barrier" ::: "memory")
#define AT_LOAD(t, S) do { const int kb_ = (t) * 64; \
        { int rr = kb_ + c0r; rr = rr < T_ ? rr : T_ - 1; gk0[S] = *(const GAS u32x4*)(KV + (rowbase + rr) * 2048 + h * 128 + c0c * 8); } \
        { int rr = kb_ + c1r; rr = rr < T_ ? rr : T_ - 1; gk1[S] = *(const GAS u32x4*)(KV + (rowbase + rr) * 2048 + h * 128 + c0c * 8); } \
        { int rr = kb_ + rkr; rr = rr < T_ ? rr : T_ - 1; gv[S] = *(const GAS u32x4*)(KR + (rowbase + rr) * 32 + rkc * 8); } } while (0)
#define AT_STORE(buf, S) do { *(LAS u32x4*)(lds + d0off + (buf) * dboff) = gk0[S]; *(LAS u32x4*)(lds + d1off + (buf) * dboff) = gk1[S]; \
        *(LAS u32x4*)(lds + (buf) * AT_KB + drope) = gv[S]; } while (0)
        AT_LOAD(0, 0); AT_STORE(0, 0);
        if (nt > 1) AT_LOAD(1, 1);
        if (nt > 2) AT_LOAD(2, 0);
        AT_BAR();
        for (int t2 = 0; t2 < nt; t2 += 2) {
#pragma unroll
          for (int hf = 0; hf < 2; ++hf) {
            const int t = t2 + hf, cur = hf;
            if (t < nt) {
            if (t * 64 <= qwmax && qwmin < qend) {
                const LAS unsigned char* kb = lds + cur * AT_KB; const LAS unsigned char* vb = lds + 2 * AT_KB + cur * AT_VB;
                f32x16 p0, p1;
#pragma unroll
                for (int i = 0; i < 16; ++i) { p0[i] = -m_run; p1[i] = -m_run; }
                bf16x8 kf[12], vf[8];
#pragma unroll
                for (int ks = 0; ks < 6; ++ks) { kf[2 * ks] = *(const LAS bf16x8*)(kb + r * AT_KP + (16 * ks + 8 * hh) * 2); kf[2 * ks + 1] = *(const LAS bf16x8*)(kb + (32 + r) * AT_KP + (16 * ks + 8 * hh) * 2); }
#pragma unroll
                for (int i8 = 0; i8 < 8; ++i8) { const int kbk = i8 >> 2, s = (i8 >> 1) & 1, dv = i8 & 1;
                    const LAS unsigned char* va = vb + (32 * kbk + 16 * s + 4 * hh + q4) * AT_VP + dv * 64 + 32 * blk + 8 * p4;
                    const s16x4 lo = vtr(va), hi = vtr(va + 8 * AT_VP);
                    vf[i8] = (bf16x8){lo[0], lo[1], lo[2], lo[3], hi[0], hi[1], hi[2], hi[3]}; }
                __builtin_amdgcn_sched_barrier(0);
#pragma unroll
                for (int ks = 0; ks < 6; ++ks) { p0 = MFMA32(kf[2 * ks], qf[ks], p0); p1 = MFMA32(kf[2 * ks + 1], qf[ks], p1); }
                __builtin_amdgcn_sched_barrier(0);
                if (t * 64 + 63 > qwmin) {
#pragma unroll
                    for (int i = 0; i < 16; ++i) { const int kv = t * 64 + (i & 3) + 8 * (i >> 2) + 4 * hh;
                        if (kv > qrow) p0[i] = -INFINITY; if (kv + 32 > qrow) p1[i] = -INFINITY; }
                }
                float mxa = fmaxf(p0[0], p1[0]), mxb = fmaxf(p0[1], p1[1]);
#pragma unroll
                for (int i = 2; i < 16; i += 2) { mxa = fmaxf(fmaxf(mxa, p0[i]), p1[i]); mxb = fmaxf(fmaxf(mxb, p0[i + 1]), p1[i + 1]); }
                float mx = fmaxf(mxa, mxb);
                { const auto sw_ = __builtin_amdgcn_permlane32_swap(__float_as_uint(mx), __float_as_uint(mx), false, false); mx = fmaxf(__uint_as_float(sw_[0]), __uint_as_float(sw_[1])); }
                if (t == 0 || __builtin_amdgcn_ballot_w64(mx > 8.0f) != 0ull) {
                    const float d = (t == 0) ? mx : fmaxf(mx, 0.f), alpha = __builtin_amdgcn_exp2f(-d);
                    m_run += d; l_run *= alpha;
#pragma unroll
                    for (int i = 0; i < 16; ++i) { p0[i] -= d; p1[i] -= d; o[0][i] *= alpha; o[1][i] *= alpha; }
                }
                float rsa = 0.f, rsb = 0.f;
#pragma unroll
                for (int i = 0; i < 16; ++i) { p0[i] = __builtin_amdgcn_exp2f(p0[i]); p1[i] = __builtin_amdgcn_exp2f(p1[i]);
                    asm("v_add_f32_e32 %0, %1, %2" : "=v"(rsa) : "v"(rsa), "v"(p0[i])); asm("v_add_f32_e32 %0, %1, %2" : "=v"(rsb) : "v"(rsb), "v"(p1[i])); }
                const float rs = rsa + rsb;
                l_run += rs;
#pragma unroll
                for (int kbk = 0; kbk < 2; ++kbk)
#pragma unroll
                    for (int s = 0; s < 2; ++s) {
                        u32x4 pw;
                        if (kbk == 0) { pw.x = pk2(p0[8 * s], p0[8 * s + 1]); pw.y = pk2(p0[8 * s + 2], p0[8 * s + 3]); pw.z = pk2(p0[8 * s + 4], p0[8 * s + 5]); pw.w = pk2(p0[8 * s + 6], p0[8 * s + 7]); }
                        else { pw.x = pk2(p1[8 * s], p1[8 * s + 1]); pw.y = pk2(p1[8 * s + 2], p1[8 * s + 3]); pw.z = pk2(p1[8 * s + 4], p1[8 * s + 5]); pw.w = pk2(p1[8 * s + 6], p1[8 * s + 7]); }
                        const bf16x8 pf = __builtin_bit_cast(bf16x8, pw);
#pragma unroll
                        for (int dv = 0; dv < 2; ++dv) o[dv] = MFMA32(vf[kbk * 4 + s * 2 + dv], pf, o[dv]);
                    }
            }
            if (t + 1 < nt) AT_STORE(cur ^ 1, hf ^ 1);
            if (t + 3 < nt) AT_LOAD(t + 3, hf ^ 1);
            AT_BAR();
            }
          }
        }
        if (qrow < qend) {
            const float il = 1.0f / (l_run + __shfl_xor(l_run, 32));
            bf16_t* op = AB + (rowbase + qrow) * 2048 + 1024 + h * 64;
#pragma unroll
            for (int dv = 0; dv < 2; ++dv)
#pragma unroll
                for (int gq = 0; gq < 4; ++gq) { u32x2 w; w.x = pk2(o[dv][4 * gq] * il, o[dv][4 * gq + 1] * il); w.y = pk2(o[dv][4 * gq + 2] * il, o[dv][4 * gq + 3] * il);
                    *(u32x2*)(op + dv * 32 + 8 * gq + 4 * hh) = w; }
        }
    }
    }
    __builtin_amdgcn_s_setprio(0);
#undef AT_LOAD
#undef AT_BAR
#undef AT_STORE
}

#define XB_TMO      128
#define XB_XCNT(j)  (256  + 64 * (j))
#define XB_XSUB(j)  (1280 + 64 * (j))
#define XB_XGEN(j)  (2304 + 64 * (j))
#define XB_TOP      3328
#define XB_TOPGEN   3392
#define XCD_BAR_WORDS 3456
#define XB_SPIN_CAP (1u << 18)

__device__ __forceinline__ unsigned xb_ld(unsigned* p)              { return __hip_atomic_load(p, __ATOMIC_RELAXED, __HIP_MEMORY_SCOPE_AGENT); }
__device__ __forceinline__ unsigned xb_add(unsigned* p, unsigned v) { return __hip_atomic_fetch_add(p, v, __ATOMIC_RELAXED, __HIP_MEMORY_SCOPE_AGENT); }
__device__ __forceinline__ unsigned xb_xcc_id() { return (unsigned)__builtin_amdgcn_s_getreg((3 << 11) | 20) & 0xFu; }
#define XB_SPIN(cond, bar) do { unsigned _sp = 0; while (cond) { __builtin_amdgcn_s_sleep(1); \
    if ((++_sp & 255u) == 0u) { if (xb_ld(&(bar)[XB_TMO])) break; if (_sp > XB_SPIN_CAP) { atomicAdd(&(bar)[XB_TMO], 1u); break; } } } } while (0)

struct XcdBarrier {
    unsigned* bar; unsigned x;
    volatile LAS unsigned* st;
};

__device__ __forceinline__ XcdBarrier xcd_barrier_post(unsigned* bar, volatile LAS unsigned* st, int wv_) {
    XcdBarrier b; b.bar = bar; b.x = xb_xcc_id(); b.st = st;
    if (tid_opaque() == 0) (void)xb_add(&bar[XB_XCNT(b.x)], 1u);
    return b;
}
__device__ __forceinline__ void xcd_barrier_complete(unsigned* bar, unsigned x, unsigned& nloc, unsigned& nx) {
    const unsigned G = gridDim.x * gridDim.y * gridDim.z;
    unsigned sum, cnt, mine, sp = 0u;
    for (;;) {
        sum = 0u; cnt = 0u; mine = 0u;
#pragma unroll
        for (unsigned j = 0; j < 16; ++j) { const unsigned c = xb_ld(&bar[XB_XCNT(j)]); sum += c; cnt += (c > 0u) ? 1u : 0u; mine = (j == x) ? c : mine; }
        if (sum == G) break;
        __builtin_amdgcn_s_sleep(1);
        if ((++sp & 255u) == 0u) { if (xb_ld(&bar[XB_TMO])) break; if (sp > XB_SPIN_CAP) { atomicAdd(&bar[XB_TMO], 1u); break; } }
    }
    nloc = mine > 0u ? mine : 1u; nx = cnt > 0u ? cnt : 1u;
}

__device__ __forceinline__ void xcd_barrier(const XcdBarrier& b, int wv_) {
    asm volatile("s_waitcnt vmcnt(0)" ::: "memory");
    __syncthreads();
    if (tid_opaque() == 0) {
        unsigned* bar = b.bar;
        __builtin_amdgcn_s_waitcnt(0);
        unsigned nloc = b.st[0], nx = b.st[1];
        if (nloc == 0u) { xcd_barrier_complete(bar, b.x, nloc, nx); b.st[0] = nloc; b.st[1] = nx; }
        const unsigned old = xb_add(&bar[XB_XSUB(b.x)], 1u);
        const unsigned gen = old / nloc;
        if (old + 1u == (gen + 1u) * nloc) {
            __builtin_amdgcn_fence(__ATOMIC_RELEASE, "agent");
            asm volatile("s_waitcnt vmcnt(0)" ::: "memory");
            const unsigned og = xb_add(&bar[XB_TOP], 1u);
            const unsigned tg = og / nx;
            if (og + 1u == (tg + 1u) * nx) xb_add(&bar[XB_TOPGEN], 1u);
            else XB_SPIN(xb_ld(&bar[XB_TOPGEN]) == tg, bar);
            __builtin_amdgcn_fence(__ATOMIC_ACQUIRE, "agent");
            xb_add(&bar[XB_XGEN(b.x)], 1u);
            asm volatile("s_waitcnt vmcnt(0)" ::: "memory");
        } else {
            XB_SPIN(xb_ld(&bar[XB_XGEN(b.x)]) == gen, bar);
            __builtin_amdgcn_fence(__ATOMIC_ACQUIRE, "agent");
            asm volatile("s_waitcnt vmcnt(0)" ::: "memory");
        }
    }
    __syncthreads();
}

__global__ void __launch_bounds__(NTHR) hybrid_fwd(Params P) {
    extern __shared__ __attribute__((aligned(16))) unsigned char lds_raw[];
    LAS unsigned char* lds = (LAS unsigned char*)lds_raw;
    cg::grid_group grid = cg::this_grid();
    const int wv_ = __builtin_amdgcn_readfirstlane(threadIdx.x >> 6);
    PTAB ptab = (PTAB)__builtin_amdgcn_kernarg_segment_ptr();
#if PROBE & 1
#define GBAR() do { GBAR1(); GBAR1(); } while (0)
#else
#define GBAR() GBAR1()
#endif
#define GBAR1() do { unsigned sta_ = (unsigned)LDS_CTL + 64u; asm volatile("" : "+v"(sta_)); XcdBarrier xb_; xb_.bar = (unsigned*)(WSP + WS_CTL) + 1024; xb_.x = xb_xcc_id(); \
    xb_.st = (volatile LAS unsigned*)(lds + sta_); xcd_barrier(xb_, wv_); } while (0)
#define ws WSP
#define dob OUTB
#define rstd_h ((float*)(WSP + WS_RSTDH))
#define ssqm ((float*)(WSP + WS_SSQM))
#define HB ((bf16_t*)(WSP + WS_HB))
#define WOFF(o) ((bf16_t*)(WSP + WS_W + (o)))
    { volatile LAS unsigned* st0 = (volatile LAS unsigned*)(lds + LDS_CTL + 64); if (tid_opaque() == 0) { st0[0] = 0u; st0[1] = 0u; } __syncthreads(); }
    (void)xcd_barrier_post((unsigned*)(WSP + WS_CTL) + 1024, (volatile LAS unsigned*)(lds + LDS_CTL + 64), wv_);
    unsigned my_rank_ = 0, my_xcc_ = xb_xcc_id();
    if (tid_opaque() == 0) my_rank_ = __hip_atomic_fetch_add((unsigned*)(WSP + WS_CTL) + 512 + 16 * my_xcc_, 1u, __ATOMIC_RELAXED, __HIP_MEMORY_SCOPE_AGENT);
    grid.sync();
    { volatile LAS unsigned* vc = (volatile LAS unsigned*)(lds + LDS_CTL + 128);
      if (tid_opaque() == 0) { bool ok = (gridDim.x & 7u) == 0u;
          for (int j = 0; j < 8; ++j) ok = ok && (__hip_atomic_load((unsigned*)(WSP + WS_CTL) + 512 + 16 * j, __ATOMIC_RELAXED, __HIP_MEMORY_SCOPE_AGENT) == gridDim.x / 8u);
          vc[0] = ok ? (my_rank_ * 8u + my_xcc_) : blockIdx.x; }
      __syncthreads(); }
#if PROBE & 128
    convert_layer(ptab, wv_, 0, lds);
    setup_rows(ptab, wv_);
#endif
    convert_layer(ptab, wv_, 0, lds);
    setup_rows(ptab, wv_);
    GBAR();
#pragma unroll 1
    for (int L = 0; L < 4; ++L) {
        if ((L & 1) == 0) {
            const int e = L >> 1;
            bf16_t* AB = (bf16_t*)(ws + WS_R + R_AB); bf16_t* LAT = (bf16_t*)(ws + WS_R + R_LAT); bf16_t* XKV = (bf16_t*)(ws + WS_R + R_KV); bf16_t* Qb = (bf16_t*)(dob + DO_Q);
#if PROBE & 256
            { Epi<EP_IN> E{rstd_h, AB, XKV, LAT, nullptr, nullptr, nullptr, nullptr, nullptr};
              run_gemm<EP_IN>(wv_, lds, HB, 1024, 0, WOFF(W_IN), 3328, 1024, E); }
            GBAR();
#endif
            { Epi<EP_IN> E{rstd_h, AB, XKV, LAT, nullptr, nullptr, nullptr, nullptr, nullptr};
              run_gemm<EP_IN>(wv_, lds, HB, 1024, 0, WOFF(W_IN), 3328, 1024, E); }
            GBAR();
#if PROBE & 64
            prep_phase(ptab, wv_, e); GBAR();
#endif
            prep_phase(ptab, wv_, e);
            GBAR();
#if PROBE & 2
            ssd_phase(ptab, wv_, e, lds, true); GBAR();
#endif
            ssd_phase(ptab, wv_, e, lds);
            GBAR();
#if PROBE & 512
            { Epi<EP_Q> E{(const float*)(ws + WS_RSTDQ), Qb, nullptr, nullptr, nullptr, (const float*)(ws + WS_COS), (const float*)(ws + WS_SIN), nullptr, nullptr};
              run_gemm<EP_Q>(wv_, lds, LAT, 768, 0, WOFF(W_Q), 1536, 384, E); }
            { Epi<EP_KV> E{(const float*)(ws + WS_RSTDKV), XKV, nullptr, nullptr, nullptr, nullptr, nullptr, nullptr, nullptr};
              run_gemm<EP_KV>(wv_, lds, LAT + 384, 768, 0, WOFF(W_KV), 2048, 256, E); }
            GBAR();
#endif
            { Epi<EP_Q> E{(const float*)(ws + WS_RSTDQ), Qb, nullptr, nullptr, nullptr, (const float*)(ws + WS_COS), (const float*)(ws + WS_SIN), nullptr, nullptr};
              run_gemm<EP_Q>(wv_, lds, LAT, 768, 0, WOFF(W_Q), 1536, 384, E); }
            { Epi<EP_KV> E{(const float*)(ws + WS_RSTDKV), XKV, nullptr, nullptr, nullptr, nullptr, nullptr, nullptr, nullptr};
              run_gemm<EP_KV>(wv_, lds, LAT + 384, 768, 0, WOFF(W_KV), 2048, 256, E); }
#if PROBE & 64
            fix_phase(ptab, wv_, true);
#endif
            fix_phase(ptab, wv_);
            GBAR();
#if PROBE & 4
            attn_phase(ptab, wv_, lds, (unsigned*)(ws + WS_CTL) + 6144 + 256 * e); GBAR();
#endif
            attn_phase(ptab, wv_, lds, (unsigned*)(ws + WS_CTL) + 5120 + 256 * e);
            GBAR();
#if PROBE & 4096
            { Epi<EP_M> E{nullptr, (bf16_t*)(ws + WS_M), nullptr, nullptr, ssqm, nullptr, nullptr, nullptr, nullptr};
              run_gemm<EP_M, 1>(wv_, lds, AB, 2048, 0, WOFF(W_O), 1024, 2048, E); }
            GBAR();
#endif
            { Epi<EP_M> E{nullptr, (bf16_t*)(ws + WS_M), nullptr, nullptr, ssqm, nullptr, nullptr, nullptr, nullptr};
              run_gemm<EP_M, 1>(wv_, lds, AB, 2048, 0, WOFF(W_O), 1024, 2048, E); }
        } else {
            const int o = L >> 1;
            bf16_t* X = (bf16_t*)(ws + WS_R + R_X); bf16_t* G = (bf16_t*)(ws + WS_R + R_G); bf16_t* XR = (bf16_t*)(ws + WS_R + R_XR); bf16_t* U = (bf16_t*)(dob + DO_Q);
#if PROBE & 1024
            { Epi<EP_XY> E{rstd_h, X, G, nullptr, nullptr, nullptr, nullptr, nullptr, nullptr};
              run_gemm<EP_XY>(wv_, lds, HB, 1024, 0, WOFF(W_XY), 2560, 1024, E); }
            GBAR();
#endif
            { Epi<EP_XY> E{rstd_h, X, G, nullptr, nullptr, nullptr, nullptr, nullptr, nullptr};
              run_gemm<EP_XY>(wv_, lds, HB, 1024, 0, WOFF(W_XY), 2560, 1024, E); }
            GBAR();
#if PROBE & 64
            rgconv_phase(ptab, wv_, o); GBAR();
#endif
            rgconv_phase(ptab, wv_, o);
            GBAR();
            { Epi<EP_AI> E{nullptr, X, U, nullptr, nullptr, INP(25) + o * 1280, INP(27) + o * 1280, INP(28) + o * 1280, XR};
              run_gemm<EP_AI>(wv_, lds, XR, 1280, 128, WOFF(W_AI), 2560, 128, E); }
            GBAR();
#if PROBE & 32
            scan_a_phase(ptab, wv_); GBAR(); scan_c_phase(ptab, wv_, true); GBAR();
#endif
            scan_a_phase(ptab, wv_);
            GBAR();
            scan_c_phase(ptab, wv_);
            GBAR();
            { Epi<EP_M> E{nullptr, (bf16_t*)(ws + WS_M), nullptr, nullptr, ssqm, nullptr, nullptr, nullptr, nullptr};
              run_gemm<EP_M, 1>(wv_, lds, U, 1280, 0, WOFF(W_RO), 1024, 1280, E); }
        }
        GBAR();
        { Epi<EP_PART> E{nullptr, nullptr, nullptr, nullptr, nullptr, (const float*)(ws + WS_PART), nullptr, nullptr, nullptr};
          if ((L & 1) == 0) run_gemm_tail<EP_PART>(wv_, lds, (bf16_t*)(ws + WS_R + R_AB), 2048, WOFF(W_O), 2048, 1024, 2, E);
          else run_gemm_tail<EP_PART>(wv_, lds, (bf16_t*)(dob + DO_Q), 1280, WOFF(W_RO), 1280, 640, 2, E); }
#if PROBE & 16
        resnorm_phase(ptab, wv_, lds, INP(3) + L * 1024, false, 0, MP - 256, 8, true);
#endif
        resnorm_phase(ptab, wv_, lds, INP(3) + L * 1024, false, 0, MP - 256, 8);
        GBAR();
        tail_reduce_resnorm(ptab, wv_, INP(3) + L * 1024, false, 2);
        GBAR();
#if PROBE & 8
        { Epi<EP_UP> E{rstd_h, (bf16_t*)(ws + WS_R + R_U), nullptr, nullptr, nullptr, nullptr, nullptr, nullptr, nullptr};
          run_gemm<EP_UP>(wv_, lds, HB, 1024, 0, WOFF(W_UP), 4096, 1024, E); }
        GBAR();
#endif
        { Epi<EP_UP> E{rstd_h, (bf16_t*)(ws + WS_R + R_U), nullptr, nullptr, nullptr, nullptr, nullptr, nullptr, nullptr};
          run_gemm<EP_UP>(wv_, lds, HB, 1024, 0, WOFF(W_UP), 4096, 1024, E); }
        GBAR();
#if PROBE & 2048
        { Epi<EP_M> E{nullptr, (bf16_t*)(ws + WS_M), nullptr, nullptr, ssqm, nullptr, nullptr, nullptr, nullptr};
          run_gemm<EP_M, 1>(wv_, lds, (bf16_t*)(ws + WS_R + R_U), 4096, 0, WOFF(W_DN), 1024, 4096, E); }
            GBAR();
#endif
        { Epi<EP_M> E{nullptr, (bf16_t*)(ws + WS_M), nullptr, nullptr, ssqm, nullptr, nullptr, nullptr, nullptr};
          run_gemm<EP_M, 1>(wv_, lds, (bf16_t*)(ws + WS_R + R_U), 4096, 0, WOFF(W_DN), 1024, 4096, E); }
        GBAR();
        { Epi<EP_PART> E{nullptr, nullptr, nullptr, nullptr, nullptr, (const float*)(ws + WS_PART), nullptr, nullptr, nullptr};
          run_gemm_tail<EP_PART>(wv_, lds, (bf16_t*)(ws + WS_R + R_U), 4096, WOFF(W_DN), 4096, 1024, 4, E); }
#if PROBE & 16
        resnorm_phase(ptab, wv_, lds, INP(5) + L * 1024, false, 0, MP - 256, 16, true);
#endif
        resnorm_phase(ptab, wv_, lds, INP(5) + L * 1024, L == 3, 0, MP - 256, 16);
        GBAR();
#if PROBE & 128
        if (L < 3) convert_layer(ptab, wv_, L + 1, lds);
#endif
        if (L < 3) { convert_layer(ptab, wv_, L + 1, lds); tail_reduce_resnorm(ptab, wv_, INP(5) + L * 1024, false, 4); GBAR(); }
        else tail_reduce_resnorm(ptab, wv_, INP(5) + L * 1024, true, 4);
    }
#undef WOFF
#undef ws
#undef dob
#undef rstd_h
#undef ssqm
#undef HB
}

extern "C" void kernel_launch(void* const* d_in, const int* in_sizes, int n_in, void* d_out, int out_size, void* d_ws, size_t ws_size, hipStream_t stream) {
    static int grid_blocks = 0;
    if (grid_blocks == 0) {
        if (n_in != 30 || ws_size < WS_NEED || (size_t)out_size * 4 < DO_Q + (size_t)MP * 1536 * 2) { fprintf(stderr, "kernel_launch: unexpected shapes (n_in %d, ws %zu need %zu, out %d)\n", n_in, ws_size, (size_t)WS_NEED, out_size); grid_blocks = -1; return; }
        int dev = 0, cus = 0, per_cu = 0;
        hipGetDevice(&dev); hipDeviceGetAttribute(&cus, hipDeviceAttributeMultiprocessorCount, dev);
        if (hipFuncSetAttribute((const void*)hybrid_fwd, hipFuncAttributeMaxDynamicSharedMemorySize, LDS_BYTES) != hipSuccess) { fprintf(stderr, "kernel_launch: hipFuncSetAttribute failed\n"); grid_blocks = -1; return; }
        if (hipOccupancyMaxActiveBlocksPerMultiprocessor(&per_cu, (const void*)hybrid_fwd, NTHR, LDS_BYTES) != hipSuccess || per_cu < 1) { fprintf(stderr, "kernel_launch: occupancy query says %d\n", per_cu); per_cu = 1; }
        (void)hipGetLastError();
        grid_blocks = cus * 1;
    }
    if (grid_blocks < 0) return;
    hipMemsetAsync((char*)d_ws + WS_CTL, 0, CTL_BYTES, stream);
    Params p{};
    for (int i = 0; i < 30; ++i) p.in[i] = (const float*)d_in[i];
    p.out = (float*)d_out; p.ws = (unsigned char*)d_ws;
    void* args[] = {&p};
    hipError_t e = hipLaunchCooperativeKernel((const void*)hybrid_fwd, dim3(grid_blocks), dim3(NTHR), args, LDS_BYTES, stream);
    if (e != hipSuccess) fprintf(stderr, "cooperative launch failed: %s (grid %d)\n", hipGetErrorString(e), grid_blocks);
}
```
